# Optimizing an MI355X kernel written in HIP

```python
import math
import jax, jax.numpy as jnp
from jax import lax
import numpy as np

D_MODEL = 1024
BATCH = 8
SEQ = 2048
DEPTH = 2

CHUNK = 64
Q_BLOCK = 128
A_Q_BLOCK = 64
EPS = 1e-6

A_HEADS = 8
A_HEAD_DIM = 64
IDX_HEADS = 8
IDX_DIM = 64
TOPK_MAX = 256

B_HEADS = 8
Q_LORA = 256
KV_LORA = 128
QK_NOPE = 64
QK_ROPE = 32
V_DIM = 64
ROPE_THETA = 10000.0

N_BUCKETS = 32
MAX_DISTANCE = 128

N_EXPERTS = 32
TOP_K = 4
D_EXPERT = 1024
SWIGLU_LIMIT = 7.0
SWIGLU_ALPHA = 1.702
MOE_BLOCK = 256

D_A = A_HEADS * A_HEAD_DIM
D_B = B_HEADS * V_DIM
D_MIX = D_A + D_B
IN_SIZES = (D_A, D_A, D_A, IDX_HEADS * IDX_DIM, IDX_DIM, IDX_HEADS, Q_LORA, KV_LORA, QK_ROPE)
D_IN = 3 * D_A + IDX_HEADS * IDX_DIM + IDX_DIM + IDX_HEADS + Q_LORA + KV_LORA + QK_ROPE

kernel_name = 'hybrid_dsa_mla_moe_adaln_trunk'


def rmsnorm(x, g):
    xf = x.astype(jnp.float32)
    y = xf * lax.rsqrt(jnp.mean(xf * xf, axis=-1, keepdims=True) + EPS)
    return (y * g).astype(x.dtype)


def rope(x, pos):
    half = x.shape[-1] // 2
    inv = ROPE_THETA ** (-jnp.arange(half, dtype=jnp.float32) / half)
    ang = pos.astype(jnp.float32)[..., None] * inv
    ang = ang.reshape(ang.shape[:2] + (1,) * (x.ndim - 3) + (half,))
    cos, sin = jnp.cos(ang), jnp.sin(ang)
    xf = x.astype(jnp.float32)
    x1, x2 = xf[..., :half], xf[..., half:]
    return jnp.concatenate([x1 * cos - x2 * sin, x2 * cos + x1 * sin], axis=-1).astype(x.dtype)


def t5_bucket(rel):
    nb = N_BUCKETS // 2
    max_exact = nb // 2
    ret = jnp.where(rel > 0, nb, 0)
    n = jnp.abs(rel)
    large = max_exact + (jnp.log(jnp.maximum(n, 1).astype(jnp.float32) / max_exact)
                         / math.log(MAX_DISTANCE / max_exact) * (nb - max_exact)).astype(jnp.int32)
    large = jnp.minimum(large, nb - 1)
    return ret + jnp.where(n < max_exact, n, large)


def to_blocks(t, qb):
    b, s = t.shape[:2]
    return jnp.moveaxis(t.reshape((b, s // qb, qb) + t.shape[2:]), 1, 0)


def from_blocks(t):
    nqb, b, qb = t.shape[:3]
    return jnp.moveaxis(t, 0, 1).reshape((b, nqb * qb) + t.shape[3:])


def indexer_sparse_attention(q_a, k_a, v_a, q_idx, k_idx, w_idx, pos, rel_bias):
    b, s = pos.shape
    topk = min(TOPK_MAX, s // 4)
    kv = jnp.concatenate([k_a, v_a], axis=-1)
    key_chunk = pos // CHUNK

    def block(args):
        q, qi, wi, pq = args
        rel_scores = jax.nn.relu(jnp.einsum('bqhd,bsd->bqhs', qi, k_idx))
        score = jnp.einsum('bqh,bqhs->bqs', wi, rel_scores).astype(jnp.float32)
        visible = key_chunk[:, None, :] <= (pq // CHUNK)[:, :, None]
        top_val, top_idx = lax.top_k(jnp.where(visible, score, -jnp.inf), topk)
        valid = jnp.isfinite(top_val)
        kv_sel = jax.vmap(lambda t, i: t[i])(kv, top_idx)
        k_sel, v_sel = jnp.split(kv_sel, 2, axis=-1)
        pos_sel = jax.vmap(lambda p, i: p[i])(pos, top_idx)
        bias = rel_bias[t5_bucket(pos_sel - pq[:, :, None])]
        logits = jnp.einsum('bqhd,bqkhd->bqkh', q, k_sel).astype(jnp.float32) * (A_HEAD_DIM ** -0.5) + bias
        p = jax.nn.softmax(jnp.where(valid[..., None], logits, -jnp.inf), axis=2)
        return jnp.einsum('bqkh,bqkhd->bqhd', p.astype(v_sel.dtype), v_sel)

    out = lax.map(block, (to_blocks(q_a, A_Q_BLOCK), to_blocks(q_idx, A_Q_BLOCK),
                          to_blocks(w_idx, A_Q_BLOCK), to_blocks(pos, A_Q_BLOCK)))
    return from_blocks(out)


def latent_attention(q_nope, q_rope, k_nope, k_rope, v, pos):
    scale = (QK_NOPE + QK_ROPE) ** -0.5
    key_chunk = pos // CHUNK

    def block(args):
        qn, qr, pq = args
        logits = (jnp.einsum('bqhd,bshd->bhqs', qn, k_nope)
                  + jnp.einsum('bqhd,bsd->bhqs', qr, k_rope)).astype(jnp.float32) * scale
        visible = key_chunk[:, None, None, :] <= (pq // CHUNK)[:, None, :, None]
        p = jax.nn.softmax(jnp.where(visible, logits, -jnp.inf), axis=-1)
        return jnp.einsum('bhqs,bshd->bqhd', p.astype(v.dtype), v)

    out = lax.map(block, (to_blocks(q_nope, Q_BLOCK), to_blocks(q_rope, Q_BLOCK), to_blocks(pos, Q_BLOCK)))
    return from_blocks(out)


def hybrid_mixer(h, pos, rel_bias, w_in, q_norm, w_uq, kv_norm, w_ukv, w_out):
    b, s, _ = h.shape
    offsets = np.cumsum(IN_SIZES)[:-1].tolist()
    proj = h @ w_in
    q_a, k_a, v_a, q_idx, k_idx, w_idx, c_q, c_kv, k_rope = jnp.split(proj, offsets, axis=-1)
    heads = lambda t, n: t.reshape(b, s, n, -1)
    y_a = indexer_sparse_attention(heads(q_a, A_HEADS), heads(k_a, A_HEADS), heads(v_a, A_HEADS),
                                   heads(q_idx, IDX_HEADS), k_idx, w_idx, pos, rel_bias)
    q = heads(rmsnorm(c_q, q_norm) @ w_uq, B_HEADS)
    kvb = heads(rmsnorm(c_kv, kv_norm) @ w_ukv, B_HEADS)
    y_b = latent_attention(q[..., :QK_NOPE], rope(q[..., QK_NOPE:], pos),
                           kvb[..., :QK_NOPE], rope(k_rope, pos), kvb[..., QK_NOPE:], pos)
    y = jnp.concatenate([y_a.reshape(b, s, D_A), y_b.reshape(b, s, D_B)], axis=-1)
    return y @ w_out


def clamped_swiglu(hid):
    x_glu, x_lin = jnp.split(hid, 2, axis=-1)
    x_glu = jnp.minimum(x_glu, SWIGLU_LIMIT)
    x_lin = jnp.clip(x_lin, -SWIGLU_LIMIT, SWIGLU_LIMIT)
    return x_glu * jax.nn.sigmoid(SWIGLU_ALPHA * x_glu) * (x_lin + 1.0)


def routed_moe(h, w_router, b_router, w1, b1, w2, b2):
    b, s, d = h.shape
    n = b * s
    xt = h.reshape(n, d)
    logits = (xt @ w_router + b_router).astype(jnp.float32)
    top_val, top_e = lax.top_k(logits, TOP_K)
    gate = jax.nn.softmax(top_val, axis=-1)
    nk = n * TOP_K
    flat_e = top_e.reshape(nk)
    flat_tok = jnp.repeat(jnp.arange(n, dtype=jnp.int32), TOP_K)
    flat_w = gate.reshape(nk)
    order = jnp.argsort(flat_e)
    se, stok, sw = flat_e[order], flat_tok[order], flat_w[order]
    counts = jnp.bincount(flat_e, length=N_EXPERTS)
    start = jnp.cumsum(counts) - counts
    padded = (counts + MOE_BLOCK - 1) // MOE_BLOCK * MOE_BLOCK
    pend = jnp.cumsum(padded)
    pstart = pend - padded
    dest = pstart[se] + (jnp.arange(nk) - start[se])
    n_blocks = -(-nk // MOE_BLOCK) + N_EXPERTS
    cap = n_blocks * MOE_BLOCK
    buf_tok = jnp.zeros((cap,), jnp.int32).at[dest].set(stok)
    buf_w = jnp.zeros((cap,), jnp.float32).at[dest].set(sw)
    block_e = jnp.minimum(jnp.searchsorted(pend, jnp.arange(n_blocks) * MOE_BLOCK, side='right'),
                          N_EXPERTS - 1)

    def expert_block(args):
        e, tok, w = args
        xe = xt[tok]
        y = clamped_swiglu(xe @ w1[e] + b1[e]) @ w2[e] + b2[e]
        return y * w[:, None]

    yb = lax.map(expert_block, (block_e, buf_tok.reshape(n_blocks, MOE_BLOCK), buf_w.reshape(n_blocks, MOE_BLOCK)))
    out = jax.ops.segment_sum(yb.reshape(cap, d), buf_tok, num_segments=n)
    return out.reshape(b, s, d).astype(h.dtype)


def setup_inputs(seed: int = 0) -> dict:
    key = jax.random.key(seed)
    ks = jax.random.split(key, 24)
    f32 = jnp.float32

    def nrm(k, shape, fan_in, mult=1.0):
        return jax.random.normal(k, shape, f32) * (mult * fan_in ** -0.5)

    x = jax.random.normal(ks[0], (BATCH, SEQ, D_MODEL), f32)
    c = jax.random.normal(ks[1], (BATCH, D_MODEL), f32)
    offset = jax.random.randint(ks[2], (BATCH, 1), 0, 64) * CHUNK
    positions = (offset + jnp.arange(SEQ, dtype=jnp.int32)[None, :]).astype(jnp.int32)
    return {
        'x': x,
        'c': c,
        'positions': positions,
        'rel_bias': 0.2 * jax.random.normal(ks[3], (N_BUCKETS, A_HEADS), f32),
        'norm_mix': 1.0 + 0.02 * jax.random.normal(ks[4], (DEPTH, D_MODEL), f32),
        'w_ada': nrm(ks[5], (DEPTH, D_MODEL, 6 * D_MODEL), D_MODEL, 0.5),
        'b_ada': 0.02 * jax.random.normal(ks[6], (DEPTH, 6 * D_MODEL), f32),
        'w_in': nrm(ks[7], (DEPTH, D_MODEL, D_IN), D_MODEL),
        'q_norm': 1.0 + 0.02 * jax.random.normal(ks[8], (DEPTH, Q_LORA), f32),
        'w_uq': nrm(ks[9], (DEPTH, Q_LORA, B_HEADS * (QK_NOPE + QK_ROPE)), Q_LORA),
        'kv_norm': 1.0 + 0.02 * jax.random.normal(ks[10], (DEPTH, KV_LORA), f32),
        'w_ukv': nrm(ks[11], (DEPTH, KV_LORA, B_HEADS * (QK_NOPE + V_DIM)), KV_LORA),
        'w_out': nrm(ks[12], (DEPTH, D_MIX, D_MODEL), D_MIX),
        'norm_ffn': 1.0 + 0.02 * jax.random.normal(ks[13], (DEPTH, D_MODEL), f32),
        'w_router': nrm(ks[14], (DEPTH, D_MODEL, N_EXPERTS), D_MODEL),
        'b_router': 0.01 * jax.random.normal(ks[15], (DEPTH, N_EXPERTS), f32),
        'w1': nrm(ks[16], (DEPTH, N_EXPERTS, D_MODEL, 2 * D_EXPERT), D_MODEL),
        'b1': 0.02 * jax.random.normal(ks[17], (DEPTH, N_EXPERTS, 2 * D_EXPERT), f32),
        'w2': nrm(ks[18], (DEPTH, N_EXPERTS, D_EXPERT, D_MODEL), D_EXPERT),
        'b2': 0.02 * jax.random.normal(ks[19], (DEPTH, N_EXPERTS, D_MODEL), f32),
        'norm_final': 1.0 + 0.02 * jax.random.normal(ks[20], (D_MODEL,), f32),
    }


def reference(x, c, positions, rel_bias, norm_mix, w_ada, b_ada, w_in, q_norm, w_uq, kv_norm, w_ukv,
              w_out, norm_ffn, w_router, b_router, w1, b1, w2, b2, norm_final):
    cond = jax.nn.silu(c)
    for l in range(DEPTH):
        mod = (cond @ w_ada[l] + b_ada[l])[:, None, :]
        sh_m, sc_m, g_m, sh_f, sc_f, g_f = jnp.split(mod, 6, axis=-1)
        h = rmsnorm(x, norm_mix[l]) * (1.0 + sc_m) + sh_m
        x = x + g_m * hybrid_mixer(h, positions, rel_bias, w_in[l], q_norm[l], w_uq[l],
                                   kv_norm[l], w_ukv[l], w_out[l])
        h = rmsnorm(x, norm_ffn[l]) * (1.0 + sc_f) + sh_f
        x = x + g_f * routed_moe(h, w_router[l], b_router[l], w1[l], b1[l], w2[l], b2[l])
    return rmsnorm(x, norm_final)
```

```cpp
#include <hip/hip_runtime.h>
#include <hip/hip_cooperative_groups.h>
#include <cstdio>
#include <cstdint>
namespace cg = cooperative_groups;

#ifndef MULTI_LAUNCH
#define MULTI_LAUNCH 0
#endif

#ifndef PROBE_X
#define PROBE_X 0
#endif
#define LAS __attribute__((address_space(3)))
#define DI __device__ __forceinline__
typedef unsigned short bf16_t;
typedef short bf16x8 __attribute__((ext_vector_type(8)));
typedef short s16x4 __attribute__((ext_vector_type(4)));
typedef float f32x2 __attribute__((ext_vector_type(2)));
typedef float f32x4 __attribute__((ext_vector_type(4)));
typedef float f32x16 __attribute__((ext_vector_type(16)));
typedef unsigned u32x2 __attribute__((ext_vector_type(2)));
typedef unsigned u32x4 __attribute__((ext_vector_type(4)));
typedef __bf16 bf16x2_t __attribute__((ext_vector_type(2)));

constexpr int DM = 1024, BATCH = 8, SEQ = 2048, NTOK = BATCH * SEQ, DEPTH = 2;
constexpr int D_IN = 2536, D_INP = 2560;
constexpr int NE = 32, DEXP = 1024;
constexpr int CAP_TILES = 288, CAP_ROWS = CAP_TILES * 256;
constexpr float EPS = 1e-6f;
constexpr float LOG2E = 1.4426950408889634f;
constexpr int PC_QA = 0, PC_KA = 512, PC_VA = 1024, PC_QI = 1536, PC_KI = 2048, PC_CQ = 2112, PC_CKV = 2368, PC_KR = 2496, PC_WI = 2528;

constexpr size_t MiB = 1u << 20;
constexpr size_t WS_CTL = 0, CTL_BYTES = 64 * 1024;
constexpr size_t WS_MODS = 1 * MiB;
constexpr size_t WS_ROPE = 2 * MiB;
constexpr size_t WS_WIN = 4 * MiB;
constexpr size_t WS_WUP = 14 * MiB;
constexpr size_t WS_WOUT = 16 * MiB;
constexpr size_t WS_W1 = 20 * MiB;
constexpr size_t WS_W2 = 276 * MiB;
constexpr size_t WS_HBUF = 404 * MiB;
constexpr size_t WS_PROJ = 436 * MiB;
constexpr size_t WS_CQN = 516 * MiB;
constexpr size_t WS_CKVN = 524 * MiB;
constexpr size_t WS_KR = 532 * MiB;
constexpr size_t WS_UPO = 533 * MiB;
constexpr int UPO_LD = 1792;
constexpr size_t WS_MASK = 589 * MiB;
constexpr size_t WS_YBUF = 593 * MiB;
constexpr size_t WS_XR = 625 * MiB;
constexpr size_t WS_ME = 689 * MiB;
constexpr size_t WS_MR = 690 * MiB;
constexpr size_t WS_MG = 691 * MiB;
constexpr size_t WS_DEST = 692 * MiB;
constexpr size_t WS_YEXP = 693 * MiB;
constexpr size_t WS_XP8 = 837 * MiB;
constexpr size_t WS_WIN8 = 860 * MiB;
constexpr size_t WS_H8IN = 870 * MiB;
constexpr size_t WS_HID8 = 909 * MiB;
constexpr float W_SCALE = 64.f, X_SCALE = 8.f, H_SCALE = 4.f, Y_SCALE = 16.f, YE_SCALE = 16.f;
constexpr size_t WS_RANKTOK = 981 * MiB;
constexpr size_t WS_END = 983 * MiB;
constexpr int CW_GCNT = 64;
constexpr int CW_BAR = 4096;
constexpr int CW_MISMATCH = 32;

constexpr int SCR_BYTES = 133120;
constexpr int LC_OFF = SCR_BYTES;
constexpr int LC_BARST = LC_OFF;
constexpr int LC_PST = LC_OFF + 64;
constexpr int LC_TILEE = LC_OFF + 256;
constexpr int LC_MISC = LC_OFF + 256 + 1280;
constexpr int LC_CNT = LC_OFF + 1792;
constexpr int LC_DEFER = LC_OFF + 2048;
constexpr int SLOT_IN = 3, SLOT_MOE = 2;
constexpr int RT_OFF = SCR_BYTES + 4096;
constexpr int LDS_BYTES = RT_OFF + 9 * 1024;

struct P {
    const float *x, *c; const int* pos; const float *rel_bias, *norm_mix, *w_ada, *b_ada, *w_in, *q_norm, *w_uq, *kv_norm, *w_ukv, *w_out,
        *norm_ffn, *w_router, *b_router, *w1, *b1, *w2, *b2, *norm_final;
    float* out; unsigned char* ws;
};

typedef __attribute__((address_space(4))) const P* KP;

DI unsigned cvtpk(float lo, float hi) { f32x2 v = {lo, hi}; bf16x2_t b = __builtin_convertvector(v, bf16x2_t); return __builtin_bit_cast(unsigned, b); }
DI float clamp8(float x) { return fminf(fmaxf(x, -448.f), 448.f); }
DI unsigned pk4_fp8(float a, float b, float c, float d) { int w = 0; w = __builtin_amdgcn_cvt_pk_fp8_f32(clamp8(a), clamp8(b), w, false); w = __builtin_amdgcn_cvt_pk_fp8_f32(clamp8(c), clamp8(d), w, true); return (unsigned)w; }
DI unsigned pk4_fp8_nc(float a, float b, float c, float d) { int w = 0; w = __builtin_amdgcn_cvt_pk_fp8_f32(a, b, w, false); w = __builtin_amdgcn_cvt_pk_fp8_f32(c, d, w, true); return (unsigned)w; }
DI float bflo(unsigned u) { return __uint_as_float(u << 16); }
DI float bfhi(unsigned u) { return __uint_as_float(u & 0xffff0000u); }
DI float bf1(bf16_t h) { return __uint_as_float((unsigned)h << 16); }
DI float wave_sum(float v, int lane) {
#pragma unroll
    for (int o = 1; o < 64; o <<= 1) v += __int_as_float(__builtin_amdgcn_ds_bpermute((lane ^ o) << 2, __float_as_int(v)));
    return v;
}
DI float xor32_max(float m) { auto rr = __builtin_amdgcn_permlane32_swap(__float_as_uint(m), __float_as_uint(m), false, false); return fmaxf(__uint_as_float(rr[0]), __uint_as_float(rr[1])); }
DI float xor32_sum(float m) { auto rr = __builtin_amdgcn_permlane32_swap(__float_as_uint(m), __float_as_uint(m), false, false); return __uint_as_float(rr[0]) + __uint_as_float(rr[1]); }
DI int crow(int r, int hi) { return (r & 3) + 8 * (r >> 2) + 4 * hi; }
#define LDS_WAIT() asm volatile("s_waitcnt lgkmcnt(0)" ::: "memory")
#define VM_WAIT() asm volatile("s_waitcnt vmcnt(0)" ::: "memory")

struct Ctx {
    LAS unsigned char* lds;
    int tid, lane, wave, G, vcu, gw, NGW, bx;
    int rbase, rcnt, lw, NLW;
    unsigned char* ws;
};

#define XB_TMO      128
#define XB_XCNT(j)  (256  + 64 * (j))
#define XB_XSUB(j)  (1280 + 64 * (j))
#define XB_XGEN(j)  (2304 + 64 * (j))
#define XB_TOP      3328
#define XB_TOPGEN   3392
#define XCD_BAR_WORDS 3456
#define XB_SPIN_CAP (1u << 22)
DI unsigned xb_ld(unsigned* p) { return __hip_atomic_load(p, __ATOMIC_RELAXED, __HIP_MEMORY_SCOPE_AGENT); }
DI unsigned xb_add(unsigned* p, unsigned v) { return __hip_atomic_fetch_add(p, v, __ATOMIC_RELAXED, __HIP_MEMORY_SCOPE_AGENT); }
DI unsigned xb_xcc_id() { return (unsigned)__builtin_amdgcn_s_getreg((3 << 11) | 20) & 0xFu; }
#define XB_SPIN(cond, bar) do { unsigned _sp = 0; while (cond) { __builtin_amdgcn_s_sleep(1); \
    if ((++_sp & 255u) == 0u) { if (xb_ld(&(bar)[XB_TMO])) break; if (_sp > XB_SPIN_CAP) { atomicAdd(&(bar)[XB_TMO], 1u); break; } } } } while (0)
struct XcdBarrier { unsigned* bar; unsigned x; volatile LAS unsigned* st; };
DI XcdBarrier xcd_barrier_post(unsigned* bar, volatile LAS unsigned* st, int tid) {
    XcdBarrier b; b.bar = bar; b.x = xb_xcc_id(); b.st = st;
    if (tid == 0) (void)xb_add(&bar[XB_XCNT(b.x)], 1u);
    return b;
}
DI void xcd_barrier_complete(unsigned* bar, unsigned x, unsigned& nloc, unsigned& nx) {
    const unsigned G = gridDim.x * gridDim.y * gridDim.z;
    unsigned sum, cnt, mine, sp = 0u;
    for (;;) {
        sum = 0u; cnt = 0u; mine = 0u;
#pragma unroll
        for (unsigned j = 0; j < 16; ++j) { const unsigned c = xb_ld(&bar[XB_XCNT(j)]); sum += c; cnt += (c > 0u) ? 1u : 0u; mine = (j == x) ? c : mine; }
        if (sum == G) break;
        __builtin_amdgcn_s_sleep(1);
        if ((++sp & 255u) == 0u) { if (xb_ld(&bar[XB_TMO])) break; if (sp > XB_SPIN_CAP) { atomicAdd(&bar[XB_TMO], 1u); break; } }
    }
    nloc = mine > 0u ? mine : 1u; nx = cnt > 0u ? cnt : 1u;
}
DI void xcd_barrier(const XcdBarrier& b, int tid, const bool local_seam = false) {
    asm volatile("s_waitcnt vmcnt(0)" ::: "memory");
    __syncthreads();
    if (tid == 0) {
        unsigned* bar = b.bar;
        __builtin_amdgcn_s_waitcnt(0);
        unsigned nloc = b.st[0], nx = b.st[1];
        if (nloc == 0u) { xcd_barrier_complete(bar, b.x, nloc, nx); b.st[0] = nloc; b.st[1] = nx; }
        const unsigned old = xb_add(&bar[XB_XSUB(b.x)], 1u);
        const unsigned gen = old / nloc;
        if (local_seam && b.st[2] != 0u) {
            if (old + 1u == (gen + 1u) * nloc) xb_add(&bar[XB_XGEN(b.x)], 1u);
            else XB_SPIN(xb_ld(&bar[XB_XGEN(b.x)]) == gen, bar);
            __builtin_amdgcn_fence(__ATOMIC_ACQUIRE, "agent");
            asm volatile("s_waitcnt vmcnt(0)" ::: "memory");
        } else if (old + 1u == (gen + 1u) * nloc) {
            __builtin_amdgcn_fence(__ATOMIC_RELEASE, "agent");
            asm volatile("s_waitcnt vmcnt(0)" ::: "memory");
            const unsigned og = xb_add(&bar[XB_TOP], 1u);
            const unsigned tg = og / nx;
            if (og + 1u == (tg + 1u) * nx) xb_add(&bar[XB_TOPGEN], 1u);
            else XB_SPIN(xb_ld(&bar[XB_TOPGEN]) == tg, bar);
            __builtin_amdgcn_fence(__ATOMIC_ACQUIRE, "agent");
            xb_add(&bar[XB_XGEN(b.x)], 1u);
            asm volatile("s_waitcnt vmcnt(0)" ::: "memory");
        } else {
            XB_SPIN(xb_ld(&bar[XB_XGEN(b.x)]) == gen, bar);
            __builtin_amdgcn_fence(__ATOMIC_ACQUIRE, "agent");
            asm volatile("s_waitcnt vmcnt(0)" ::: "memory");
        }
    }
    __syncthreads();
}

namespace pg8 {
constexpr int BM = 256, BK = 64, HALF = 128, HTB = HALF * BK * 2, NXCD = 8, WGM = 8;
DI int lds_byte(int r, int c) { const int st = (r >> 4) * 2 + (c >> 5), rr = r & 15, cc = c & 31, ob = rr * 64 + cc * 2; return st * 1024 + (ob ^ (((ob >> 9) & 1) << 5)); }
DI void stage_rc(int b, int& R, int& C) { const int st = b / 1024, sb = b % 1024, swz = sb ^ (((sb >> 9) & 1) << 5); R = (st >> 1) * 16 + swz / 64; C = (st & 1) * 32 + (swz % 64) / 2; }
DI int f8_swz(int r) { return ((r >> 1) & 7) ^ ((((r >> 2) ^ (r >> 3)) & 1) << 1); }
DI int lds_byte_f8(int r, int chunk) { return r * 128 + ((chunk ^ f8_swz(r & 15)) << 4); }
DI void stage_rc_f8(int b, int& R, int& C) { R = b >> 7; C = (((b >> 4) & 7) ^ f8_swz(R & 15)) << 3; }
DI int perm32(int rho) { const int n = rho >> 4, i = rho & 15; return 8 * (i >> 2) + 4 * n + (i & 3); }
struct Unit { int pm, pn, half; };
DI bool order_next(int i, int G, int c, int nM, int nN, Unit& u, const int WGM = 8, const bool split = false) {
    const int nwg = nM * nN; long L = (long)i * G + c; u.half = 0;
    if (split && G == 256) { const int F = nwg >> 8, R = nwg & 255;
        if (i == F && R > 0 && R <= 128) { const int t = (c & 7) + 8 * (c >> 4); if (t >= R) return false; L = (long)F * 256 + t; u.half = 1 + ((c >> 3) & 1); } }
    if (L >= nwg) return false;
    int wgid = (int)L; { const int q = nwg / NXCD, r = nwg % NXCD, xcd = wgid % NXCD, off = wgid / NXCD; wgid = (xcd < r ? xcd * (q + 1) : r * (q + 1) + (xcd - r) * q) + off; }
    const int nig = WGM * nN, gid = wgid / nig, fm = gid * WGM, gsz = (nM - fm) < WGM ? (nM - fm) : WGM;
    u.pm = fm + ((wgid % nig) % gsz); u.pn = (wgid % nig) / gsz; return true;
}
typedef int v8i32 __attribute__((ext_vector_type(8)));
template <bool F8, bool GATHER, class Epi, class Sched>
DI void gemm_phase(LAS unsigned char* lds, const int tid, const int K, const Sched& S, const Epi& E) {
    const int wid = __builtin_amdgcn_readfirstlane(tid >> 6), lane = tid & 63, wr = wid >> 2, wc = wid & 3, fr = lane & 15, fq = lane >> 4;
    int nt = K / BK; asm volatile("" : "+s"(nt));
    unsigned voffA[2], voffB[2]; int rowA[2];
#pragma unroll
    for (int i = 0; i < 2; ++i) { int R, C; if constexpr (F8) stage_rc_f8(tid * 16 + i * 8192, R, C); else stage_rc(tid * 16 + i * 8192, R, C); const int Rb = Epi::PERM ? ((R & ~31) + perm32(R & 31)) : R;
        voffA[i] = GATHER ? (unsigned)C * 2u : (unsigned)(R * K + C) * 2u; voffB[i] = (unsigned)(Rb * K + C) * 2u; rowA[i] = R; }
    unsigned va[2][2], vn[2][2];
#define PG8_ROWS(dst, ui_) do { if constexpr (GATHER) { const LAS int* rt_ = S.rowtab(ui_); _Pragma("unroll") for (int h_ = 0; h_ < 2; ++h_) _Pragma("unroll") for (int i_ = 0; i_ < 2; ++i_) dst[h_][i_] = (unsigned)rt_[h_ * 128 + rowA[i_]] + voffA[i_]; } } while (0)
#define PG8_STAGE_A(bufoff, abase, h, NEXT) do { if constexpr (GATHER) { const unsigned vo_[2] = {(NEXT) ? vn[h][0] : va[h][0], (NEXT) ? vn[h][1] : va[h][1]}; PG8_STAGE(bufoff, abase, vo_); } \
        else { PG8_STAGE(bufoff, (abase) + (h) * hstep, voffA); } } while (0)
    const size_t kstep = (size_t)(BK * 2);
    const size_t hstep = (size_t)HALF * K * 2;
    const unsigned ldsw = (unsigned)wid * 1024u;
    const int aoff = F8 ? lds_byte_f8(wr * 64 + fr, 2 * fq) : lds_byte(wr * 64 + fr, fq * 8), boff = F8 ? lds_byte_f8(wc * 32 + fr, 2 * fq) : lds_byte(wc * 32 + fr, fq * 8);
    const int aoffx = F8 ? (aoff ^ 16) : aoff + 1024, boffx = F8 ? (boff ^ 16) : boff + 1024;
#define PG8_SA(b, h) (((b) * 2 + (h)) * HTB)
#define PG8_SB(b, h) ((4 + (b) * 2 + (h)) * HTB)
#define PG8_STAGE(bufoff, gbase, voff) do { _Pragma("unroll") for (int _i = 0; _i < 2; ++_i) \
        __builtin_amdgcn_global_load_lds((const unsigned*)((const char*)(gbase) + (voff)[_i]), (LAS unsigned*)(lds + (bufoff) + ldsw + _i * 8192), 16, 0, 0); } while (0)
#define PG8_LDA(dst, b, h) do { _Pragma("unroll") for (int m = 0; m < 4; ++m) _Pragma("unroll") for (int k = 0; k < 2; ++k) dst[m][k] = *(const LAS bf16x8*)(lds + PG8_SA(b, h) + (k ? aoffx : aoff) + m * 2048); } while (0)
#define PG8_LDB(dst, b, h) do { _Pragma("unroll") for (int n = 0; n < 2; ++n) _Pragma("unroll") for (int k = 0; k < 2; ++k) dst[n][k] = *(const LAS bf16x8*)(lds + PG8_SB(b, h) + (k ? boffx : boff) + n * 2048); } while (0)
#define PG8_J8(X) __builtin_bit_cast(v8i32, __builtin_shufflevector((X)[0], (X)[1], 0, 1, 2, 3, 4, 5, 6, 7, 8, 9, 10, 11, 12, 13, 14, 15))
#define PG8_MMA(ai, bj, At, Bt) do { __builtin_amdgcn_s_setprio(1); _Pragma("unroll") for (int m = 0; m < 4; ++m) _Pragma("unroll") for (int n = 0; n < 2; ++n) { \
        if constexpr (F8) { asm volatile("v_mfma_scale_f32_16x16x128_f8f6f4 %0, %1, %2, %0, %3, %3 op_sel_hi:[0,0,0]" : "+v"(acc[ai][bj][m][n]) : "v"(PG8_J8(Bt[n])), "v"(PG8_J8(At[m])), "v"(0x7f7f7f7f)); } \
        else { _Pragma("unroll") for (int k = 0; k < 2; ++k) acc[ai][bj][m][n] = __builtin_amdgcn_mfma_f32_16x16x32_bf16(Bt[n][k], At[m][k], acc[ai][bj][m][n], 0, 0, 0); } } \
        __builtin_amdgcn_s_setprio(0); } while (0)
#define PG8_WAIT_V(n) asm volatile("s_waitcnt vmcnt(" #n ")" ::: "memory")
#define PG8_WAIT_L(n) asm volatile("s_waitcnt lgkmcnt(" #n ")" ::: "memory")
#define PG8_BAR __builtin_amdgcn_s_barrier()
#define PG8_SCHED __builtin_amdgcn_sched_barrier(0)
    Unit cur, nxt; int ui = 0; bool ft = false;
    if (!S.next(0, cur)) return;
    f32x4 acc[2][2][4][2];
#pragma unroll
    for (int a = 0; a < 2; ++a)
#pragma unroll
        for (int b = 0; b < 2; ++b)
#pragma unroll
            for (int m = 0; m < 4; ++m)
#pragma unroll
                for (int n = 0; n < 2; ++n) acc[a][b][m][n] = (f32x4){0.f, 0.f, 0.f, 0.f};
    bf16x8 At[4][2], B0[2][2], B1[2][2];
    typename Epi::Pre pre;
    const char* cA = S.aptr(cur); const char* cB = S.bptr(cur);
    PG8_ROWS(va, 0);
    PG8_STAGE(PG8_SB(0, 0), cB, voffB); PG8_STAGE(PG8_SB(0, 1), cB + hstep, voffB); PG8_STAGE_A(PG8_SA(0, 0), cA, 0, false); PG8_STAGE_A(PG8_SA(0, 1), cA, 1, false);
    if (wr == 1) PG8_BAR;
    PG8_WAIT_V(2); PG8_BAR;
    PG8_STAGE(PG8_SB(1, 0), cB + kstep, voffB); PG8_STAGE_A(PG8_SA(1, 0), cA + kstep, 0, false); PG8_STAGE(PG8_SB(1, 1), cB + hstep + kstep, voffB);
    PG8_WAIT_V(6); PG8_BAR;
    for (;;) {
        const bool has_next = S.next(ui + 1, nxt);
        const char* nA = has_next ? S.aptr(nxt) : cA; const char* nB = has_next ? S.bptr(nxt) : cB;
        const bool do0 = cur.half != 2, do1 = cur.half != 1;
        if constexpr (GATHER) { if (has_next) PG8_ROWS(vn, ui + 1); else { _Pragma("unroll") for (int h_ = 0; h_ < 2; ++h_) _Pragma("unroll") for (int i_ = 0; i_ < 2; ++i_) vn[h_][i_] = va[h_][i_]; } }
#pragma clang loop unroll(disable)
        for (int t = 0; t < nt; t += 2) {
            const bool last = (t == nt - 2);
            const bool skipw = Epi::DRAIN && ft && t == 0;
            if constexpr (Epi::EARLY == 1) { if (last) E.prefetch(cur, wr, wc, pre); } else if constexpr (Epi::EARLY == 2) { if (last) E.prefetch_dma(cur, wc, lds + 8 * HTB + wid * 256); }
            const char* a1 = cA + (size_t)(t + 1) * kstep;
            const char* a2 = last ? nA : cA + (size_t)(t + 2) * kstep; const char* b2 = last ? nB : cB + (size_t)(t + 2) * kstep;
            const char* a3 = a2 + kstep; const char* b3 = b2 + kstep;
            PG8_LDB(B0, 0, 0); PG8_LDB(B1, 0, 1); PG8_SCHED; if (do0) PG8_LDA(At, 0, 0); PG8_STAGE_A(PG8_SA(1, 1), a1, 1, false);
            if (!skipw) PG8_WAIT_V(8); PG8_WAIT_L(0); PG8_BAR; if (do0) { PG8_MMA(0, 0, At, B0); PG8_MMA(0, 1, At, B1); } PG8_BAR; PG8_SCHED;
            if (do1) PG8_LDA(At, 0, 1); PG8_STAGE(PG8_SB(0, 0), b2, voffB); PG8_STAGE(PG8_SB(0, 1), b2 + hstep, voffB); PG8_STAGE_A(PG8_SA(0, 0), a2, 0, last);
            if (!skipw) PG8_WAIT_V(8); PG8_WAIT_L(0); PG8_BAR; if (do1) { PG8_MMA(1, 0, At, B0); PG8_MMA(1, 1, At, B1); } PG8_BAR; PG8_SCHED;
            PG8_LDB(B0, 1, 0); PG8_LDB(B1, 1, 1); PG8_SCHED; if (do0) PG8_LDA(At, 1, 0); PG8_STAGE_A(PG8_SA(0, 1), a2, 1, last);
            PG8_WAIT_V(8); PG8_WAIT_L(0); PG8_BAR; if (do0) { PG8_MMA(0, 0, At, B0); PG8_MMA(0, 1, At, B1); } PG8_BAR; PG8_SCHED;
            if (do1) PG8_LDA(At, 1, 1); PG8_STAGE(PG8_SB(1, 0), b3, voffB); PG8_STAGE(PG8_SB(1, 1), b3 + hstep, voffB); PG8_STAGE_A(PG8_SA(1, 0), a3, 0, last);
            PG8_WAIT_V(8); PG8_WAIT_L(0); PG8_BAR; if (do1) { PG8_MMA(1, 0, At, B0); PG8_MMA(1, 1, At, B1); } PG8_BAR; PG8_SCHED;
        }
        if (wr == 0) PG8_BAR;
        if constexpr (F8) asm volatile("s_nop 15\n\ts_nop 15" ::: "memory");
        if constexpr (Epi::EARLY == 0) E.prefetch(cur, wr, wc, pre); else if constexpr (Epi::EARLY == 2) E.load_pre(lds + 8 * HTB + wid * 256, pre);
        E(acc, cur, wr, wc, fr, fq, pre);
        if (!has_next) break;
#pragma unroll
        for (int a = 0; a < 2; ++a)
#pragma unroll
            for (int b = 0; b < 2; ++b)
#pragma unroll
                for (int m = 0; m < 4; ++m)
#pragma unroll
                    for (int n = 0; n < 2; ++n) acc[a][b][m][n] = (f32x4){0.f, 0.f, 0.f, 0.f};
        cur = nxt; cA = nA; cB = nB; ++ui; ft = true;
        if constexpr (GATHER) { _Pragma("unroll") for (int h_ = 0; h_ < 2; ++h_) _Pragma("unroll") for (int i_ = 0; i_ < 2; ++i_) va[h_][i_] = vn[h_][i_]; }
        if (wr == 1) PG8_BAR;
    }
    PG8_WAIT_V(0);
    PG8_BAR;
#undef PG8_SA
#undef PG8_SB
#undef PG8_STAGE
#undef PG8_STAGE_A
#undef PG8_ROWS
#undef PG8_LDA
#undef PG8_LDB
#undef PG8_MMA
#undef PG8_J8
#undef PG8_WAIT_V
#undef PG8_WAIT_L
#undef PG8_BAR
#undef PG8_SCHED
}
}
using pg8::Unit;

struct SchedDense {
    const char* A; const char* B; int nM, nN, G, c; size_t tstep; bool split = false;
    DI bool next(int i, Unit& u) const { return pg8::order_next(i, G, c, nM, nN, u, 8, split); }
    DI const char* aptr(const Unit& u) const { return A + (size_t)u.pm * tstep; }
    DI const char* bptr(const Unit& u) const { return B + (size_t)u.pn * tstep; }
    DI const LAS int* rowtab(int) const { return nullptr; }
};
struct SchedUp {
    const char *A, *B; int G, c;
    DI bool next(int i, Unit& u) const { return pg8::order_next(i, G, c, NTOK / 256, 7, u); }
    DI const char* aptr(const Unit& u) const { return A + (size_t)(u.pn >= 3 ? 1 : 0) * (WS_CKVN - WS_CQN) + (size_t)u.pm * (256 * 256 * 2); }
    DI const char* bptr(const Unit& u) const { return B + (size_t)u.pn * (256 * 256 * 2); }
    DI const LAS int* rowtab(int) const { return nullptr; }
};
#ifndef MOE_WGM
#define MOE_WGM 4
#endif
struct SchedMoe {
    const char* A; const char* B; const LAS int* tile_e; int nM, nN, G, c; bool split = false;
    DI bool next(int i, Unit& u) const { return pg8::order_next(i, G, c, nM, nN, u, MOE_WGM, split); }
    DI const char* aptr(const Unit& u) const { return A + (size_t)u.pm * (256 * 1024); }
    DI const char* bptr(const Unit& u) const { return B + ((size_t)__builtin_amdgcn_readfirstlane(tile_e[u.pm]) * nN + u.pn) * (256 * 1024); }
    DI const LAS int* rowtab(int) const { return nullptr; }
};
struct SchedMoeG {
    const char* A; const char* B; const LAS int* tile_e; const LAS int* rowtab_; int nM, nN, G, c; bool split = false;
    DI bool next(int i, Unit& u) const { return pg8::order_next(i, G, c, nM, nN, u, MOE_WGM, split); }
    DI const char* aptr(const Unit&) const { return A; }
    DI const char* bptr(const Unit& u) const { return B + ((size_t)__builtin_amdgcn_readfirstlane(tile_e[u.pm]) * nN + u.pn) * (256 * 1024); }
    DI const LAS int* rowtab(int ui) const { return rowtab_ + ui * 256; }
};

#define EPI_DRAIN() asm volatile("s_waitcnt vmcnt(0)" ::: "memory")
#define EPI_LANE0() int z0_ = 0; asm volatile("" : "+v"(z0_)); const int ln0_ = (int)__builtin_amdgcn_mbcnt_hi(~0u, __builtin_amdgcn_mbcnt_lo(~0u, (unsigned)z0_)); const int fq = ln0_ >> 4
#define EPI_LANE() int z_ = 0; asm volatile("" : "+v"(z_)); const int ln_ = (int)__builtin_amdgcn_mbcnt_hi(~0u, __builtin_amdgcn_mbcnt_lo(~0u, (unsigned)z_)); const int fr = ln_ & 15, fq = ln_ >> 4; (void)fr_; (void)fq_
struct PreNone { };
struct Pre4 { f32x4 v[2][2]; };
struct EpiProj {
    static constexpr int EARLY = 0; static constexpr bool DRAIN = true; static constexpr bool PERM = true; bf16_t* O; int ldc; float sc; typedef PreNone Pre;
    DI void prefetch(const Unit&, int, int, Pre&) const {}
    DI void operator()(const f32x4 (&acc)[2][2][4][2], const Unit& u, int wr, int wc, int fr_, int fq_, const Pre&) const {
        EPI_LANE();
        const int row0 = u.pm * 256 + wr * 64 + fr, col0 = u.pn * 256 + wc * 32 + 8 * fq; u32x4 ow[2][4][2];
#pragma unroll
        for (int ai = 0; ai < 2; ++ai)
#pragma unroll
            for (int m = 0; m < 4; ++m) {
#pragma unroll
                for (int bj = 0; bj < 2; ++bj) { const f32x4 v0 = acc[ai][bj][m][0] * sc, v1 = acc[ai][bj][m][1] * sc;
                    u32x4 w; w.x = cvtpk(v0[0], v0[1]); w.y = cvtpk(v0[2], v0[3]); w.z = cvtpk(v1[0], v1[1]); w.w = cvtpk(v1[2], v1[3]); ow[ai][m][bj] = w; } }
        EPI_DRAIN();
#pragma unroll
        for (int ai = 0; ai < 2; ++ai)
#pragma unroll
            for (int m = 0; m < 4; ++m) { if (u.half != 0 && ai != u.half - 1) continue;     bf16_t* rowp = O + (size_t)(row0 + ai * 128 + m * 16) * ldc + col0;
#pragma unroll
                for (int bj = 0; bj < 2; ++bj) *(u32x4*)(rowp + bj * 128) = ow[ai][m][bj]; }
    }
};
template <bool SRC_F32>
struct EpiOut {
    static constexpr int EARLY = 0; static constexpr bool DRAIN = false; static constexpr bool PERM = false; bf16_t* XR; const float* xsrc; const float* gm; float sc; typedef Pre4 Pre;
    DI void prefetch(const Unit& u, int wr, int wc, Pre& pre) const { EPI_LANE0(); const int col0 = u.pn * 256 + wc * 32 + 4 * fq; const int b = u.pm >> 3;
#pragma unroll
        for (int bj = 0; bj < 2; ++bj)
#pragma unroll
            for (int n = 0; n < 2; ++n) pre.v[bj][n] = *(const f32x4*)(gm + b * 6144 + col0 + bj * 128 + n * 16) * sc; }
    DI void operator()(const f32x4 (&acc)[2][2][4][2], const Unit& u, int wr, int wc, int fr_, int fq_, const Pre& pre) const {
        EPI_LANE();
        const int row0 = u.pm * 256 + wr * 64 + fr, col0 = u.pn * 256 + wc * 32 + 4 * fq;
        const f32x4 (&g)[2][2] = pre.v;
#pragma unroll
        for (int ai = 0; ai < 2; ++ai)
#pragma unroll
            for (int m = 0; m < 4; ++m) { const size_t ro = (size_t)(row0 + ai * 128 + m * 16) * DM + col0;
#pragma unroll
                for (int bj = 0; bj < 2; ++bj)
#pragma unroll
                    for (int n = 0; n < 2; ++n) { const size_t o = ro + bj * 128 + n * 16; f32x4 r;
                        if constexpr (SRC_F32) r = *(const f32x4*)(xsrc + o); else { const u32x2 w = *(const u32x2*)(XR + o); r = (f32x4){bflo(w.x), bfhi(w.x), bflo(w.y), bfhi(w.y)}; }
                        r = r + g[bj][n] * acc[ai][bj][m][n];
                        u32x2 ow; ow.x = cvtpk(r[0], r[1]); ow.y = cvtpk(r[2], r[3]); *(u32x2*)(XR + o) = ow; } }
    }
};
struct EpiSwiglu {
    static constexpr int EARLY = 2; static constexpr bool DRAIN = true; static constexpr bool PERM = true; unsigned char* O; const float* b1; const LAS int* tile_e; typedef Pre4 Pre;
    DI void prefetch(const Unit& u, int wr, int wc, Pre& pre) const { EPI_LANE0(); const int e = __builtin_amdgcn_readfirstlane(tile_e[u.pm]); const float* bb = b1 + e * 2048 + u.pn * 128 + wc * 32 + 8 * fq;
        pre.v[0][0] = *(const f32x4*)(bb); pre.v[0][1] = *(const f32x4*)(bb + 4); pre.v[1][0] = *(const f32x4*)(bb + 1024); pre.v[1][1] = *(const f32x4*)(bb + 1028); }
    DI void prefetch_dma(const Unit& u, int wc, LAS unsigned char* slot) const { int z0_ = 0; asm volatile("" : "+v"(z0_)); const int ln0_ = (int)__builtin_amdgcn_mbcnt_hi(~0u, __builtin_amdgcn_mbcnt_lo(~0u, (unsigned)z0_));
        const int e = __builtin_amdgcn_readfirstlane(tile_e[u.pm]); const float* src = b1 + e * 2048 + u.pn * 128 + wc * 32 + (ln0_ & 31) + (ln0_ >> 5) * 1024;
        __builtin_amdgcn_global_load_lds((const unsigned*)src, (LAS unsigned*)slot, 4, 0, 0); }
    DI void load_pre(const LAS unsigned char* slot, Pre& pre) const { EPI_LANE0(); const LAS float* sl_ = (const LAS float*)slot + 8 * fq;
        pre.v[0][0] = *(const LAS f32x4*)(sl_); pre.v[0][1] = *(const LAS f32x4*)(sl_ + 4); pre.v[1][0] = *(const LAS f32x4*)(sl_ + 32); pre.v[1][1] = *(const LAS f32x4*)(sl_ + 36); }
    DI void operator()(const f32x4 (&acc)[2][2][4][2], const Unit& u, int wr, int wc, int fr_, int fq_, const Pre& pre) const {
        EPI_LANE();
        const int row0 = u.pm * 256 + wr * 64 + fr, col0 = u.pn * 128 + wc * 32 + 8 * fq;
        constexpr float sc = 1.0f / (X_SCALE * W_SCALE); u32x2 ow[2][4];
        const f32x4 bg0 = pre.v[0][0], bg1 = pre.v[0][1], bl0 = pre.v[1][0], bl1 = pre.v[1][1];
#pragma unroll
        for (int ai = 0; ai < 2; ++ai)
#pragma unroll
            for (int m = 0; m < 4; ++m) { if (u.half != 0 && ai != u.half - 1) continue;
                float r[8];
#pragma unroll
                for (int q = 0; q < 4; ++q) { const f32x4 ag = acc[ai][0][m][q >> 1], al = acc[ai][1][m][q >> 1]; const f32x4 bg = (q >> 1) ? bg1 : bg0, bl = (q >> 1) ? bl1 : bl0; const int o = 2 * (q & 1);
                    f32x2 g = (f32x2){ag[o], ag[o + 1]} * sc + (f32x2){bg[o], bg[o + 1]}; f32x2 l = (f32x2){al[o], al[o + 1]} * sc + (f32x2){bl[o], bl[o + 1]};
                    g.x = fminf(g.x, 7.0f); g.y = fminf(g.y, 7.0f); l.x = __builtin_amdgcn_fmed3f(l.x, -7.0f, 7.0f); l.y = __builtin_amdgcn_fmed3f(l.y, -7.0f, 7.0f);
                    f32x2 t = g * (-1.702f * LOG2E); t.x = __builtin_amdgcn_exp2f(t.x); t.y = __builtin_amdgcn_exp2f(t.y);
                    f32x2 d = t + 1.0f; d.x = __builtin_amdgcn_rcpf(d.x); d.y = __builtin_amdgcn_rcpf(d.y);
                    const f32x2 lh = l * H_SCALE + H_SCALE; const f32x2 y = (g * d) * lh;
                    r[2 * q] = y.x; r[2 * q + 1] = y.y; }
                u32x2 w; w.x = pk4_fp8_nc(r[0], r[1], r[2], r[3]); w.y = pk4_fp8_nc(r[4], r[5], r[6], r[7]);
                ow[ai][m] = w; }
        EPI_DRAIN();
#pragma unroll
        for (int ai = 0; ai < 2; ++ai)
#pragma unroll
            for (int m = 0; m < 4; ++m) { if (u.half != 0 && ai != u.half - 1) continue;
                *(u32x2*)(O + (size_t)(row0 + ai * 128 + m * 16) * DEXP + col0) = ow[ai][m]; }
    }
};
struct EpiDown {
    static constexpr int EARLY = 1; static constexpr bool DRAIN = true; static constexpr bool PERM = true; unsigned char* O; const float* b2; const LAS int* tile_e; typedef Pre4 Pre;
    DI void prefetch(const Unit& u, int wr, int wc, Pre& pre) const { EPI_LANE0(); const int e = __builtin_amdgcn_readfirstlane(tile_e[u.pm]); const int col0 = u.pn * 256 + wc * 32 + 8 * fq;
#pragma unroll
        for (int bj = 0; bj < 2; ++bj)
#pragma unroll
            for (int n = 0; n < 2; ++n) pre.v[bj][n] = *(const f32x4*)(b2 + e * 1024 + col0 + bj * 128 + 4 * n); }
    DI void operator()(const f32x4 (&acc)[2][2][4][2], const Unit& u, int wr, int wc, int fr_, int fq_, const Pre& pre) const {
        EPI_LANE();
        const int row0 = u.pm * 256 + wr * 64 + fr, col0 = u.pn * 256 + wc * 32 + 8 * fq;
        const f32x4 (&bv)[2][2] = pre.v; u32x2 ow[2][4][2];
#pragma unroll
        for (int ai = 0; ai < 2; ++ai)
#pragma unroll
            for (int m = 0; m < 4; ++m) { if (u.half != 0 && ai != u.half - 1) continue;
#pragma unroll
                for (int bj = 0; bj < 2; ++bj) { constexpr float sc = YE_SCALE / (H_SCALE * W_SCALE); const f32x4 v0 = acc[ai][bj][m][0] * sc + bv[bj][0] * YE_SCALE, v1 = acc[ai][bj][m][1] * sc + bv[bj][1] * YE_SCALE;
                    u32x2 w; w.x = pk4_fp8(v0[0], v0[1], v0[2], v0[3]); w.y = pk4_fp8(v1[0], v1[1], v1[2], v1[3]); ow[ai][m][bj] = w; } }
        EPI_DRAIN();
#pragma unroll
        for (int ai = 0; ai < 2; ++ai)
#pragma unroll
            for (int m = 0; m < 4; ++m) { if (u.half != 0 && ai != u.half - 1) continue; unsigned char* rowp = O + (size_t)(row0 + ai * 128 + m * 16) * DM + col0;
#pragma unroll
                for (int bj = 0; bj < 2; ++bj) *(u32x2*)(rowp + bj * 128) = ow[ai][m][bj]; }
    }
};

template <class RM>
DI void transpose_item(const float* W, int K, int N, bf16_t* WT, int ldt, LAS float* scr, int kb, int nb, int lane, RM rm) {
    const int k0 = 64 * kb, n0 = 32 * nb; const int nn = n0 + (lane & 31); const bool ok = nn < N;
#pragma unroll 8
    for (int i = 0; i < 32; ++i) { const int kk = 2 * i + (lane >> 5); scr[kk * 33 + (lane & 31)] = ok ? W[(size_t)(k0 + kk) * N + nn] : 0.f; }
    LDS_WAIT(); asm volatile("" ::: "memory");
    const int c = lane & 7;
#pragma unroll
    for (int j = 0; j < 4; ++j) { const int nl = (lane >> 3) + 8 * j; const int n = n0 + nl; const LAS float* s = scr + (8 * c) * 33 + nl;
        u32x4 o; o.x = cvtpk(s[0 * 33], s[1 * 33]); o.y = cvtpk(s[2 * 33], s[3 * 33]); o.z = cvtpk(s[4 * 33], s[5 * 33]); o.w = cvtpk(s[6 * 33], s[7 * 33]);
        if (n < N) *(u32x4*)(WT + (size_t)rm(n) * ldt + k0 + 8 * c) = o; }
    LDS_WAIT(); asm volatile("" ::: "memory");
}
template <class RM>
DI void transpose_item_f8(const float* W, int K, int N, unsigned char* WT, int ldt, LAS float* scr, int kb, int nb, int lane, RM rm, float sc) {
    const int k0 = 64 * kb, n0 = 32 * nb; const int nl = lane & 31, kh = lane >> 5;
#pragma unroll 8
    for (int i = 0; i < 32; ++i) { const int kk = 2 * i + kh; scr[kk * 33 + nl] = W[(size_t)(k0 + kk) * N + n0 + nl]; }
    LDS_WAIT(); asm volatile("" ::: "memory");
    const LAS float* s = scr + (32 * kh) * 33 + nl; unsigned w[8];
#pragma unroll
    for (int i = 0; i < 8; ++i) w[i] = pk4_fp8(s[(4 * i) * 33] * sc, s[(4 * i + 1) * 33] * sc, s[(4 * i + 2) * 33] * sc, s[(4 * i + 3) * 33] * sc);
    unsigned char* d = WT + (size_t)rm(n0 + nl) * ldt + k0 + 32 * kh;
    *(u32x4*)d = (u32x4){w[0], w[1], w[2], w[3]}; *(u32x4*)(d + 16) = (u32x4){w[4], w[5], w[6], w[7]};
    LDS_WAIT(); asm volatile("" ::: "memory");
}
struct RmId { DI int operator()(int n) const { return n; } };
struct RmIn { DI int operator()(int n) const { return n < 2112 ? n : (n < 2120 ? PC_WI + (n - 2112) : n - 8); } };
struct RmW1 { DI int operator()(int n) const { const int j = n & 1023; return 256 * (j >> 7) + (n >= 1024 ? 128 : 0) + (j & 127); } };

struct TDesc { const float* src; unsigned char* dst; int N, ldt, k0, n0, kind; };
DI void t_decode(KP p, unsigned char* ws, int it, TDesc& d) {
    constexpr int I_IN = 16 * 80, I_UQ = 4 * 24, I_UKV = 2 * 32, I_OUT = 16 * 32, I_W1 = 16 * 64, I_W2 = 16 * 32;
    constexpr int I_LAYER = I_IN + I_UQ + I_UKV + I_OUT + 32 * (I_W1 + I_W2);
    const int l = it / I_LAYER; int r = it % I_LAYER;
    if (r < I_IN) { d.src = p->w_in + (size_t)l * 1024 * D_IN; d.N = D_IN; d.k0 = 64 * (r / 80); d.n0 = 32 * (r % 80);
        if (d.n0 < PC_QI) { d.dst = ws + WS_WIN8 + (size_t)l * PC_QI * 1024; d.ldt = 1024; d.kind = 2; } else { d.dst = ws + WS_WIN + (size_t)l * D_INP * 1024 * 2; d.ldt = 2048; d.kind = 1; }
        return; } r -= I_IN;
    if (r < I_UQ) { d.src = p->w_uq + (size_t)l * 256 * 768; d.N = 768; d.dst = ws + WS_WUP + (size_t)l * 1792 * 256 * 2; d.ldt = 512; d.k0 = 64 * (r / 24); d.n0 = 32 * (r % 24); d.kind = 0; return; } r -= I_UQ;
    if (r < I_UKV) { d.src = p->w_ukv + (size_t)l * 128 * 1024; d.N = 1024; d.dst = ws + WS_WUP + ((size_t)l * 1792 + 768) * 256 * 2; d.ldt = 512; d.k0 = 64 * (r / 32); d.n0 = 32 * (r % 32); d.kind = 0; return; } r -= I_UKV;
    if (r < I_OUT) { d.src = p->w_out + (size_t)l * 1024 * 1024; d.N = 1024; d.dst = ws + WS_WOUT + (size_t)l * 1024 * 1024; d.ldt = 1024; d.k0 = 64 * (r / 32); d.n0 = 32 * (r % 32); d.kind = 2; return; } r -= I_OUT;
    if (r < 32 * I_W1) { const int e = r / I_W1, q = r % I_W1; d.src = p->w1 + ((size_t)l * 32 + e) * 1024 * 2048; d.N = 2048; d.dst = ws + WS_W1 + ((size_t)l * 32 + e) * 2048 * 1024; d.ldt = 1024; d.k0 = 64 * (q / 64); d.n0 = 32 * (q % 64); d.kind = 3; return; } r -= 32 * I_W1;
    { const int e = r / I_W2, q = r % I_W2; d.src = p->w2 + ((size_t)l * 32 + e) * 1024 * 1024; d.N = 1024; d.dst = ws + WS_W2 + ((size_t)l * 32 + e) * 1024 * 1024; d.ldt = 1024; d.k0 = 64 * (q / 32); d.n0 = 32 * (q % 32); d.kind = 2; }
}
DI void t_load(const TDesc& d, int lane, f32x4 (&r)[8]) {
    const int kk = lane >> 3, nq = 4 * (lane & 7); const bool ok = d.n0 + nq < d.N;
    const float* s = d.src + (size_t)(d.k0 + kk) * d.N + d.n0 + nq;
#pragma unroll
    for (int i = 0; i < 8; ++i) r[i] = ok ? __builtin_nontemporal_load((const f32x4*)(s + (size_t)(8 * i) * d.N)) : (f32x4){0.f, 0.f, 0.f, 0.f};
}
DI void t_store(const TDesc& d, LAS float* scr, int lane, const f32x4 (&r)[8]) {
    { const int kk = lane >> 3, nq = 4 * (lane & 7);
#pragma unroll
      for (int i = 0; i < 8; ++i)
#pragma unroll
          for (int e = 0; e < 4; ++e) scr[(8 * i + kk) * 33 + nq + e] = r[i][e]; }
    LDS_WAIT(); asm volatile("" ::: "memory");
    if (d.kind < 2) {
        const int cc = lane & 7;
#pragma unroll
        for (int j = 0; j < 4; ++j) { const int nl = (lane >> 3) + 8 * j; const int n = d.n0 + nl; const LAS float* s = scr + (8 * cc) * 33 + nl;
            u32x4 o; o.x = cvtpk(s[0 * 33], s[1 * 33]); o.y = cvtpk(s[2 * 33], s[3 * 33]); o.z = cvtpk(s[4 * 33], s[5 * 33]); o.w = cvtpk(s[6 * 33], s[7 * 33]);
            const int row = d.kind == 1 ? (n < 2112 ? n : (n < 2120 ? PC_WI + (n - 2112) : n - 8)) : n;
            if (n < d.N) *(u32x4*)(d.dst + (size_t)row * d.ldt + (d.k0 + 8 * cc) * 2) = o; }
    } else {
        const int nl = lane & 31, kh = lane >> 5; const LAS float* s = scr + (32 * kh) * 33 + nl; unsigned w[8];
#pragma unroll
        for (int i = 0; i < 8; ++i) w[i] = pk4_fp8(s[(4 * i) * 33] * W_SCALE, s[(4 * i + 1) * 33] * W_SCALE, s[(4 * i + 2) * 33] * W_SCALE, s[(4 * i + 3) * 33] * W_SCALE);
        const int n = d.n0 + nl; const int jn = n & 1023;
        const int row = d.kind == 3 ? 256 * (jn >> 7) + (n >= 1024 ? 128 : 0) + (jn & 127) : n;
        unsigned char* o = d.dst + (size_t)row * d.ldt + d.k0 + 32 * kh;
        *(u32x4*)o = (u32x4){w[0], w[1], w[2], w[3]}; *(u32x4*)(o + 16) = (u32x4){w[4], w[5], w[6], w[7]};
    }
    LDS_WAIT(); asm volatile("" ::: "memory");
}
DI void big_src(KP p, int it, const float*& src, int& N, size_t& dstoff, int& k0, int& n0, int& w1map) {
    constexpr int I_W1 = 8 * 8, I_W2 = 8 * 4, I_L = 32 * (I_W1 + I_W2);
    const int l = it / I_L; int r = it % I_L;
    if (r < 32 * I_W1) { const int e = r / I_W1, q = r % I_W1; src = p->w1 + ((size_t)l * 32 + e) * 1024 * 2048; N = 2048; dstoff = WS_W1 + ((size_t)l * 32 + e) * 2048 * 1024; k0 = 128 * (q / 8); n0 = 256 * (q % 8); w1map = 1; }
    else { r -= 32 * I_W1; const int e = r / I_W2, q = r % I_W2; src = p->w2 + ((size_t)l * 32 + e) * 1024 * 1024; N = 1024; dstoff = WS_W2 + ((size_t)l * 32 + e) * 1024 * 1024; k0 = 128 * (q / 4); n0 = 256 * (q % 4); w1map = 0; }
}
DI void big_load(const float* src, int N, int k0, int n0, int wave, int lane, f32x4 (&r)[16]) {
    const float* s = src + (size_t)(k0 + 16 * wave) * N + n0 + 4 * lane;
#pragma unroll
    for (int i = 0; i < 16; ++i) r[i] = __builtin_nontemporal_load((const f32x4*)(s + (size_t)i * N));
}
constexpr int BIG_TOTAL = DEPTH * 32 * (8 * 8 + 8 * 4), BIG_L1 = 32 * (8 * 8 + 8 * 4), BIG_ND = 1024;
DI void big_convert(KP p, const Ctx& c, int first, int stride, int count, int limit, int thr, int add) {
    constexpr int TP = 260;
    LAS float* tile = (LAS float*)c.lds;
    const float* src; int N, k0, n0, w1m; size_t doff; f32x4 rc[16], rn[16];
    int r = first, j = 0;
    bool have = count > 0 && r < limit;
    if (have) { big_src(p, r + (r >= thr ? add : 0), src, N, doff, k0, n0, w1m); big_load(src, N, k0, n0, c.wave, c.lane, rc); }
    while (have) {
        const int rn_ = r + stride; ++j; const bool hn = j < count && rn_ < limit;
        const float* nsrc = src; int nN = N, nk0 = k0, nn0 = n0, nw1 = w1m; size_t ndoff = doff;
        if (hn) { big_src(p, rn_ + (rn_ >= thr ? add : 0), nsrc, nN, ndoff, nk0, nn0, nw1); big_load(nsrc, nN, nk0, nn0, c.wave, c.lane, rn); }
#pragma unroll
        for (int i = 0; i < 16; ++i) *(LAS f32x4*)(tile + (16 * c.wave + i) * TP + 4 * c.lane) = rc[i];
        __syncthreads();
        { const int nl = c.tid >> 1, kh = c.tid & 1;
          const LAS float* t0 = tile + (64 * kh) * TP + nl; unsigned w[16];
#pragma unroll
          for (int i = 0; i < 16; ++i) w[i] = pk4_fp8(t0[(4 * i) * TP] * W_SCALE, t0[(4 * i + 1) * TP] * W_SCALE, t0[(4 * i + 2) * TP] * W_SCALE, t0[(4 * i + 3) * TP] * W_SCALE);
          const int n = n0 + nl; const int jn = n & 1023; const int row = w1m ? 256 * (jn >> 7) + (n >= 1024 ? 128 : 0) + (jn & 127) : n;
          unsigned char* o = c.ws + doff + (size_t)row * 1024 + k0 + 64 * kh;
#pragma unroll
          for (int q = 0; q < 4; ++q) *(u32x4*)(o + 16 * q) = (u32x4){w[4 * q], w[4 * q + 1], w[4 * q + 2], w[4 * q + 3]}; }
        __syncthreads();
        if (!hn) break;
        src = nsrc; N = nN; k0 = nk0; n0 = nn0; w1m = nw1; doff = ndoff; r = rn_;
#pragma unroll
        for (int i = 0; i < 16; ++i) rc[i] = rn[i];
    }
}
DI void phase_prologue(KP p, const Ctx& c) {
    LAS float* scr = (LAS float*)(c.lds + c.wave * 16384);
    bf16_t* WUP = (bf16_t*)(c.ws + WS_WUP);
    {
        constexpr int I_SMALL = 16 * 80 + 4 * 24 + 2 * 32 + 16 * 32;
        constexpr int I_LAYER = I_SMALL + 32 * (16 * 64 + 16 * 32);
        for (int j = c.gw; j < DEPTH * I_SMALL; j += c.NGW) { const int it = (j / I_SMALL) * I_LAYER + (j % I_SMALL);
            TDesc dc; f32x4 rc[8]; t_decode(p, c.ws, it, dc); t_load(dc, c.lane, rc); t_store(dc, scr, c.lane, rc); }
    }
    __syncthreads();
    big_convert(p, c, c.vcu, c.G, 1 << 20, BIG_TOTAL - BIG_ND, BIG_L1, BIG_ND);
    __syncthreads();
    for (int i = c.gw * 64 + c.lane; i < DEPTH * 1024 * 16; i += c.NGW * 64) { const int l = i >> 14, row = (i >> 4) & 1023, ch = i & 15; *(u32x4*)(WUP + ((size_t)l * 1792 + 768 + row) * 256 + 128 + ch * 8) = (u32x4){0u, 0u, 0u, 0u}; }
    {
        float* ROPE = (float*)(c.ws + WS_ROPE);
        for (int i = c.gw * 64 + c.lane; i < NTOK * 16; i += c.NGW * 64) { const int m = i >> 4, j = i & 15;
            const float inv = (float)pow(10000.0, -(double)j / 16.0);
            const float ang = (float)p->pos[m] * inv;
            const double a = (double)ang; const double n = rint(a * 0.15915494309189535); const double rr = a - n * 6.283185307179586476925;
            const float rf = (float)rr;
            ROPE[m * 32 + j] = cosf(rf); ROPE[m * 32 + 16 + j] = sinf(rf); }
    }
    __syncthreads();
    {
        LAS float* cond = (LAS float*)c.lds;
        LAS float* red = (LAS float*)(c.lds + 32768);
        float* MODS = (float*)(c.ws + WS_MODS);
        bool have = false;
        for (int it = c.vcu; it < DEPTH * 96; it += c.G) {
            if (!have) { for (int i = c.tid; i < 8192; i += 512) { const int b = i >> 10, k = i & 1023; const float v = p->c[b * 1024 + k]; cond[k * 8 + b] = v / (1.0f + __expf(-v)); } have = true; __syncthreads(); }
            const int l = it / 96, j0 = (it % 96) * 64;
            const float* W = p->w_ada + (size_t)l * 1024 * 6144 + j0 + c.lane;
            float a[8] = {0.f, 0.f, 0.f, 0.f, 0.f, 0.f, 0.f, 0.f};
#pragma unroll 32
            for (int kk = 0; kk < 128; ++kk) { const int k = c.wave * 128 + kk; const float w = W[(size_t)k * 6144];
                const f32x4 c0 = *(const LAS f32x4*)(cond + k * 8), c1 = *(const LAS f32x4*)(cond + k * 8 + 4);
                a[0] += c0[0] * w; a[1] += c0[1] * w; a[2] += c0[2] * w; a[3] += c0[3] * w; a[4] += c1[0] * w; a[5] += c1[1] * w; a[6] += c1[2] * w; a[7] += c1[3] * w; }
#pragma unroll
            for (int b = 0; b < 8; ++b) red[(c.wave * 8 + b) * 64 + c.lane] = a[b];
            __syncthreads();
            { const int b = c.tid >> 6, j = c.tid & 63; float s = p->b_ada[l * 6144 + j0 + j];
#pragma unroll
              for (int w = 0; w < 8; ++w) s += red[(w * 8 + b) * 64 + j];
              MODS[(l * 8 + b) * 6144 + j0 + j] = s; }
            __syncthreads();
        }
    }
}

DI int build_tiles(const Ctx& c, int layer) {
    const unsigned* gcnt = (const unsigned*)(c.ws + WS_CTL) + CW_GCNT + layer * 64;
    LAS int* pst = (LAS int*)(c.lds + LC_PST); LAS int* tile_e = (LAS int*)(c.lds + LC_TILEE);
    __syncthreads();
    LAS int* cnt = (LAS int*)(c.lds + LC_CNT);
    if (c.tid < 32) cnt[c.tid] = (int)__hip_atomic_load(&gcnt[c.tid], __ATOMIC_RELAXED, __HIP_MEMORY_SCOPE_AGENT);
    __syncthreads();
    if (c.tid < 64) {
        const int e = c.tid & 31; const int n = (cnt[e] + 255) >> 8; int incl = n;
#pragma unroll
        for (int o = 1; o < 32; o <<= 1) { const int v = __builtin_amdgcn_ds_bpermute(((c.tid - o) & 63) << 2, incl); if (e >= o) incl += v; }
        const int st = incl - n;
        if (c.tid < 32) { pst[e] = st; if (e == 31) pst[32] = incl; for (int i = 0; i < n; ++i) tile_e[st + i] = e; }
    }
    __syncthreads();
    return pst[32];
}
DI int reuse_tiles(const Ctx& c, int layer) {
#if MULTI_LAUNCH
    return build_tiles(c, layer);
#else
    (void)layer; __syncthreads(); return ((const LAS int*)(c.lds + LC_PST))[32];
#endif
}
DI void load_row(const float* src, int lane, f32x4 (&v)[4]) {
#pragma unroll
    for (int j = 0; j < 4; ++j) v[j] = *(const f32x4*)(src + 4 * lane + 256 * j);
}
DI void load_row_bf(const bf16_t* src, int lane, f32x4 (&v)[4]) {
#pragma unroll
    for (int j = 0; j < 4; ++j) { const u32x2 w = *(const u32x2*)(src + 4 * lane + 256 * j); v[j] = (f32x4){bflo(w.x), bfhi(w.x), bflo(w.y), bfhi(w.y)}; }
}
template <int RB>
DI void moe_combine(const Ctx& c, int m0, const float* MODS_gf  , f32x4 (&v)[RB][4]) {
    const int* ME = (const int*)(c.ws + WS_ME); const int* MR = (const int*)(c.ws + WS_MR); const float* MG = (const float*)(c.ws + WS_MG); const unsigned char* Y = c.ws + WS_YEXP;
    const LAS int* pst = (const LAS int*)(c.lds + LC_PST);
    int me[RB][4], mr[RB][4]; float mg[RB][4];
#pragma unroll
    for (int i = 0; i < RB; ++i)
#pragma unroll
        for (int k = 0; k < 4; ++k) { me[i][k] = ME[(m0 + i) * 4 + k]; mr[i][k] = MR[(m0 + i) * 4 + k]; mg[i][k] = MG[(m0 + i) * 4 + k]; }
    unsigned w[RB][4][4];
#pragma unroll
    for (int i = 0; i < RB; ++i)
#pragma unroll
        for (int k = 0; k < 4; ++k) { const int d = pst[me[i][k]] * 256 + mr[i][k]; const unsigned char* row = Y + (size_t)d * DM + 4 * c.lane;
#pragma unroll
            for (int j = 0; j < 4; ++j) w[i][k][j] = *(const unsigned*)(row + 256 * j); }
#pragma unroll
    for (int i = 0; i < RB; ++i) { const int b = (m0 + i) >> 11; f32x4 a[4];
#pragma unroll
        for (int j = 0; j < 4; ++j) a[j] = (f32x4){0.f, 0.f, 0.f, 0.f};
#pragma unroll
        for (int k = 0; k < 4; ++k) { const float g = mg[i][k] * (1.0f / YE_SCALE);
#pragma unroll
            for (int j = 0; j < 4; ++j) { const int ww = (int)w[i][k][j]; const f32x2 lo = __builtin_amdgcn_cvt_pk_f32_fp8(ww, false), hi2 = __builtin_amdgcn_cvt_pk_f32_fp8(ww, true);
                a[j][0] += g * lo[0]; a[j][1] += g * lo[1]; a[j][2] += g * hi2[0]; a[j][3] += g * hi2[1]; } }
#pragma unroll
        for (int j = 0; j < 4; ++j) { const f32x4 g = *(const f32x4*)(MODS_gf + b * 6144 + 4 * c.lane + 256 * j); v[i][j] = v[i][j] + g * a[j]; } }
}
DI float row_rinv(const f32x4 (&v)[4], int lane) {
    float s = 0.f;
#pragma unroll
    for (int j = 0; j < 4; ++j) s += (v[j][0] * v[j][0] + v[j][1] * v[j][1]) + (v[j][2] * v[j][2] + v[j][3] * v[j][3]);
    s = wave_sum(s, lane);
    return 1.0f / sqrtf(s * (1.0f / 1024.0f) + EPS);
}
DI void modulate(const f32x4 (&v)[4], float r, const float* nw, const float* sh, const float* sc, int lane, f32x4 (&h)[4]) {
#pragma unroll
    for (int j = 0; j < 4; ++j) { const int o = 4 * lane + 256 * j; const f32x4 w = *(const f32x4*)(nw + o), a = *(const f32x4*)(sc + o), s = *(const f32x4*)(sh + o);
        h[j] = v[j] * r * w * (a + 1.0f) + s; }
}
DI void store_row_bf16(bf16_t* dst, int lane, const f32x4 (&h)[4]) {
#pragma unroll
    for (int j = 0; j < 4; ++j) { u32x2 w; w.x = cvtpk(h[j][0], h[j][1]); w.y = cvtpk(h[j][2], h[j][3]); *(u32x2*)(dst + 4 * lane + 256 * j) = w; }
}

DI void phase_norm_mix(KP p, const Ctx& c, int layer) {
    bf16_t* XR = (bf16_t*)(c.ws + WS_XR); bf16_t* HB = (bf16_t*)(c.ws + WS_HBUF); const float* MODS = (const float*)(c.ws + WS_MODS);
    if (layer > 0) (void)reuse_tiles(c, layer - 1);
    constexpr int RB = 2;
    for (int mm = c.lw * RB; mm < c.rcnt; mm += c.NLW * RB) { const int m0 = c.rbase + mm;
        f32x4 v[RB][4];
#pragma unroll
        for (int i = 0; i < RB; ++i) { if (layer == 0) load_row(p->x + (size_t)(m0 + i) * DM, c.lane, v[i]); else load_row_bf(XR + (size_t)(m0 + i) * DM, c.lane, v[i]); }
        if (layer > 0) moe_combine<RB>(c, m0, MODS + (layer > 0 ? layer - 1 : 0) * 8 * 6144 + 5 * 1024, v);
#pragma unroll
        for (int i = 0; i < RB; ++i) { const int m = m0 + i, b = m >> 11; f32x4 h[4];
            if (layer > 0) store_row_bf16(XR + (size_t)m * DM, c.lane, v[i]);
            const float r = row_rinv(v[i], c.lane);
            const float* md = MODS + (layer * 8 + b) * 6144;
            modulate(v[i], r, p->norm_mix + layer * 1024, md, md + 1024, c.lane, h);
            store_row_bf16(HB + (size_t)m * DM, c.lane, h);
#pragma unroll
            for (int j = 0; j < 4; ++j) *(unsigned*)(c.ws + WS_H8IN + (size_t)m * DM + 4 * c.lane + 256 * j) = pk4_fp8(h[j][0] * X_SCALE, h[j][1] * X_SCALE, h[j][2] * X_SCALE, h[j][3] * X_SCALE); }
    }
}
DI void phase_final(KP p, const Ctx& c) {
    const bf16_t* XR = (const bf16_t*)(c.ws + WS_XR); const float* MODS = (const float*)(c.ws + WS_MODS);
    (void)reuse_tiles(c, DEPTH - 1);
    constexpr int RB = 2;
    for (int m0 = c.gw * RB; m0 < NTOK; m0 += c.NGW * RB) {
        f32x4 v[RB][4];
#pragma unroll
        for (int i = 0; i < RB; ++i) load_row_bf(XR + (size_t)(m0 + i) * DM, c.lane, v[i]);
        moe_combine<RB>(c, m0, MODS + (DEPTH - 1) * 8 * 6144 + 5 * 1024, v);
#pragma unroll
        for (int i = 0; i < RB; ++i) { const int m = m0 + i; const float r = row_rinv(v[i], c.lane);
#pragma unroll
            for (int j = 0; j < 4; ++j) { const int o = 4 * c.lane + 256 * j; const f32x4 w = *(const f32x4*)(p->norm_final + o); *(f32x4*)(p->out + (size_t)m * DM + o) = v[i][j] * r * w; } }
    }
}

DI void prep_rows(KP p, const Ctx& c, int layer) {
    const bf16_t* PROJ = (const bf16_t*)(c.ws + WS_PROJ); bf16_t* CQN = (bf16_t*)(c.ws + WS_CQN); bf16_t* CKVN = (bf16_t*)(c.ws + WS_CKVN); bf16_t* KR = (bf16_t*)(c.ws + WS_KR);
    const float* ROPE = (const float*)(c.ws + WS_ROPE);
    const f32x4 gq = *(const f32x4*)(p->q_norm + layer * 256 + 4 * c.lane); const f32x2 gk = *(const f32x2*)(p->kv_norm + layer * 128 + 2 * c.lane);
    constexpr int RB = 4;
    for (int mm = c.lw * RB; mm < c.rcnt; mm += c.NLW * RB) { const int m0 = c.rbase + mm;
        u32x2 wq[RB]; unsigned wk[RB]; float r1[RB], r2[RB], rc[RB], rs[RB];
        const int l16 = c.lane & 15;
#pragma unroll
        for (int i = 0; i < RB; ++i) { const bf16_t* pr = PROJ + (size_t)(m0 + i) * D_INP;
            wq[i] = *(const u32x2*)(pr + PC_CQ + 4 * c.lane); wk[i] = *(const unsigned*)(pr + PC_CKV + 2 * c.lane);
            r1[i] = bf1(pr[PC_KR + l16]); r2[i] = bf1(pr[PC_KR + 16 + l16]); rc[i] = ROPE[(m0 + i) * 32 + l16]; rs[i] = ROPE[(m0 + i) * 32 + 16 + l16]; }
#pragma unroll
        for (int i = 0; i < RB; ++i) { const int m = m0 + i;
            { const float x0 = bflo(wq[i].x), x1 = bfhi(wq[i].x), x2 = bflo(wq[i].y), x3 = bfhi(wq[i].y);
              const float s = wave_sum(x0 * x0 + x1 * x1 + x2 * x2 + x3 * x3, c.lane); const float r = 1.0f / sqrtf(s * (1.0f / 256.0f) + EPS);
              u32x2 o; o.x = cvtpk(x0 * r * gq[0], x1 * r * gq[1]); o.y = cvtpk(x2 * r * gq[2], x3 * r * gq[3]); *(u32x2*)(CQN + (size_t)m * 256 + 4 * c.lane) = o; }
            { const float x0 = bflo(wk[i]), x1 = bfhi(wk[i]);
              const float s = wave_sum(x0 * x0 + x1 * x1, c.lane); const float r = 1.0f / sqrtf(s * (1.0f / 128.0f) + EPS);
              *(unsigned*)(CKVN + (size_t)m * 256 + 2 * c.lane) = cvtpk(x0 * r * gk[0], x1 * r * gk[1]);
              *(unsigned*)(CKVN + (size_t)m * 256 + 128 + 2 * c.lane) = 0u; }
            if (c.lane < 16) { KR[(size_t)m * 32 + c.lane] = (bf16_t)(cvtpk(r1[i] * rc[i] - r2[i] * rs[i], 0.f) & 0xffffu); KR[(size_t)m * 32 + 16 + c.lane] = (bf16_t)(cvtpk(r2[i] * rc[i] + r1[i] * rs[i], 0.f) & 0xffffu); }
        }
    }
}
constexpr int SC_LD = 2052;
DI unsigned okey(float f) { const unsigned u = __float_as_uint(f); return (u & 0x80000000u) ? ~u : (u | 0x80000000u); }
DI void idx_load(const Ctx& c, int b, int g, bf16x8 (&qf)[8][2], u32x4& wraw, bf16x8 (&ka)[8][2]) {
    const bf16_t* PROJ = (const bf16_t*)(c.ws + WS_PROJ);
    const int qbase = 16 * g, nkb = 4 * ((g >> 2) + 1); const int l15 = c.lane & 15, l4 = c.lane >> 4;
    const bf16_t* qrow = PROJ + (size_t)(b * SEQ + qbase + l15) * D_INP;
#pragma unroll
    for (int h = 0; h < 8; ++h)
#pragma unroll
        for (int ks = 0; ks < 2; ++ks) qf[h][ks] = *(const bf16x8*)(qrow + PC_QI + 64 * h + 32 * ks + 8 * l4);
    wraw = *(const u32x4*)(qrow + PC_WI);
    const bf16_t* kbase = PROJ + (size_t)(b * SEQ + l15) * D_INP + PC_KI + 8 * l4; const size_t kstride = (size_t)16 * D_INP;
#pragma unroll
    for (int d = 0; d < 8; ++d) { const int kb = c.wave + 8 * d; const int kc = kb < nkb ? kb : 0; ka[d][0] = *(const bf16x8*)(kbase + kc * kstride); ka[d][1] = *(const bf16x8*)(kbase + kc * kstride + 32); }
}
DI void idx_scores(const Ctx& c, int b, int g, const bf16x8 (&qf)[8][2], const u32x4& w, bf16x8 (&ka)[8][2]) {
    const bf16_t* PROJ = (const bf16_t*)(c.ws + WS_PROJ); LAS float* sc = (LAS float*)c.lds;
    const int nkb = 4 * ((g >> 2) + 1); const int l15 = c.lane & 15, l4 = c.lane >> 4;
    const float wh[8] = {bflo(w.x), bfhi(w.x), bflo(w.y), bfhi(w.y), bflo(w.z), bfhi(w.z), bflo(w.w), bfhi(w.w)};
    const bf16_t* kbase = PROJ + (size_t)(b * SEQ + l15) * D_INP + PC_KI + 8 * l4; const size_t kstride = (size_t)16 * D_INP;
    const int nmine = (nkb - c.wave + 7) >> 3;
#pragma unroll 1
    for (int i0 = 0; i0 < nmine; i0 += 8) {
        if (i0 > 0) {
#pragma unroll
            for (int d = 0; d < 8; ++d) { const int kb = c.wave + 8 * (i0 + d); const int kc = kb < nkb ? kb : 0; ka[d][0] = *(const bf16x8*)(kbase + kc * kstride); ka[d][1] = *(const bf16x8*)(kbase + kc * kstride + 32); } }
#pragma unroll
        for (int d = 0; d < 8; ++d) { const int i = i0 + d; if (i < nmine) {
            const int kb = c.wave + 8 * i;
            f32x4 s = {0.f, 0.f, 0.f, 0.f};
#pragma unroll
            for (int h = 0; h < 8; ++h) { f32x4 a = {0.f, 0.f, 0.f, 0.f};
                a = __builtin_amdgcn_mfma_f32_16x16x32_bf16(ka[d][0], qf[h][0], a, 0, 0, 0);
                a = __builtin_amdgcn_mfma_f32_16x16x32_bf16(ka[d][1], qf[h][1], a, 0, 0, 0);
#pragma unroll
                for (int e = 0; e < 4; ++e) s[e] += wh[h] * fmaxf(a[e], 0.f); }
            *(LAS f32x4*)(sc + l15 * SC_LD + 16 * kb + 4 * l4) = s; } }
    }
}
DI void idx_select(const Ctx& c, int b, int g) {
    unsigned long long* MASK = (unsigned long long*)(c.ws + WS_MASK); LAS float* sc = (LAS float*)c.lds;
    const int qbase = 16 * g, nvis = 64 * ((g >> 2) + 1);
    {
        const int nj = nvis >> 6;
        for (int qq = 0; qq < 2; ++qq) {
            const int q = 2 * c.wave + qq; const LAS float* row = sc + q * SC_LD;
            unsigned long long myword = 0ull;
            if (nvis <= 256) { myword = (c.lane < nj) ? ~0ull : 0ull; }
            else {
                unsigned u[32]; unsigned umax = 0u, umin = 0xffffffffu;
#pragma unroll
                for (int j = 0; j < 32; ++j) { u[j] = (j < nj) ? okey(row[64 * j + c.lane]) : 0u; if (j < nj) { umax = umax > u[j] ? umax : u[j]; umin = umin < u[j] ? umin : u[j]; } }
#pragma unroll
                for (int o = 1; o < 64; o <<= 1) { const unsigned a = (unsigned)__builtin_amdgcn_ds_bpermute((c.lane ^ o) << 2, (int)umax), b2 = (unsigned)__builtin_amdgcn_ds_bpermute((c.lane ^ o) << 2, (int)umin); umax = umax > a ? umax : a; umin = umin < b2 ? umin : b2; }
                umax = __builtin_amdgcn_readfirstlane(umax); umin = __builtin_amdgcn_readfirstlane(umin);
                const unsigned diff = umax ^ umin; const int top = diff ? 31 - __builtin_clz(diff) : -1;
                unsigned T = top >= 31 ? 0u : (top < 0 ? umax : (umax & ~((2u << top) - 1u))); bool exact = false;
                for (int bit = top; bit >= 0; --bit) {
                    const unsigned cand = T | (1u << bit);
                    int c0 = 0, c1 = 0, c2 = 0, c3 = 0;
#pragma unroll
                    for (int j = 0; j < 32; j += 4) { c0 += (u[j] >= cand) ? 1 : 0; c1 += (u[j + 1] >= cand) ? 1 : 0; c2 += (u[j + 2] >= cand) ? 1 : 0; c3 += (u[j + 3] >= cand) ? 1 : 0; }
                    const int cl = (c0 + c1) + (c2 + c3); int cnt = 0;
#pragma unroll
                    for (int bb = 0; bb < 6; ++bb) cnt += __builtin_popcountll(__ballot((cl >> bb) & 1)) << bb;
                    if (cnt >= 256) { T = cand; if (cnt == 256) { exact = true; break; } }
                }
                int need = 0;
                if (!exact) { int gt = 0;
#pragma unroll
                    for (int j = 0; j < 32; ++j) if (j < nj) gt += __builtin_popcountll(__ballot(u[j] > T));
                    need = 256 - gt; }
                int eqbase = 0;
#pragma unroll
                for (int j = 0; j < 32; ++j) if (j < nj) {
                    unsigned long long sel;
                    if (exact) sel = __ballot(u[j] >= T);
                    else { const unsigned long long eq = __ballot(u[j] == T); const int rank = eqbase + __builtin_popcountll(eq & ((1ull << c.lane) - 1ull));
                        sel = __ballot(u[j] > T || (u[j] == T && rank < need)); eqbase += __builtin_popcountll(eq); }
                    if (c.lane == j) myword = sel;
                }
            }
            if (c.lane < 32) MASK[(size_t)(b * SEQ + qbase + q) * 32 + c.lane] = myword;
        }
    }
}
DI void phase_prep_indexer(KP p, const Ctx& c, int layer) {
    prep_rows(p, c, layer);
    for (int v = c.vcu; v < 256; v += c.G) { const int b = v >> 5, s = v & 31;
        bf16x8 qf[8][2]; u32x4 wraw; bf16x8 ka[8][2];
        idx_load(c, b, 127 - s, qf, wraw, ka);
#pragma unroll
        for (int i = 0; i < 4; ++i) { const int g = i == 0 ? 127 - s : (i == 1 ? 64 + s : (i == 2 ? 63 - s : s)); const int gn = i == 0 ? 64 + s : (i == 1 ? 63 - s : s);
            idx_scores(c, b, g, qf, wraw, ka);
            __syncthreads();
            if (i < 3) idx_load(c, b, gn, qf, wraw, ka);
            idx_select(c, b, g);
            __syncthreads(); }
    }
}

template <bool MLA>
DI void attn_unit(const Ctx& c, const float* rel_bias, int b, int h, int qb) {
    constexpr int NKS = MLA ? 6 : 4;
    constexpr int SLOTB = MLA ? 20480 : 20480;
    constexpr int XOFF = 8192, VOFF = 12288, NSLOT = 4, LUTOFF = NSLOT * SLOTB;
    const bf16_t* PROJ = (const bf16_t*)(c.ws + WS_PROJ); const bf16_t* UPO = (const bf16_t*)(c.ws + WS_UPO);
    const bf16_t* KRB = (const bf16_t*)(c.ws + WS_KR); const float* ROPE = (const float*)(c.ws + WS_ROPE);
    const unsigned long long* MASK = (const unsigned long long*)(c.ws + WS_MASK); bf16_t* YB = (bf16_t*)(c.ws + WS_YBUF);
    const int tid = c.tid, lane = c.lane, r32 = lane & 31, hi = lane >> 5, wid = c.wave;
    const int q0 = qb * 256, qw = q0 + 64 * ((wid >> 1) ^ (wid >> 2)) + 32 * (wid & 1), qglob = qw + r32; const size_t mrow = (size_t)b * SEQ + qglob;
    const int NT = 4 * (qb + 1), tmax = qw >> 6;
    const float cs = (MLA ? 0.10206207261596575f : 0.125f) * LOG2E;
    LAS unsigned char* lds = c.lds;
    const int dkey = 8 * wid + (lane >> 3), dpos = lane & 7;
    const int kchunk = dpos ^ ((dkey >> 1) & 7), vchunk = dpos ^ (((dkey >> 1) & 1) << 2);
    const char *ksrc, *vsrc, *xsrc; size_t tstepK, tstepX;
    if constexpr (MLA) { const bf16_t* rowp = UPO + ((size_t)b * SEQ + dkey) * UPO_LD + 768 + 128 * h; ksrc = (const char*)(rowp + 8 * kchunk); vsrc = (const char*)(rowp + 64 + 8 * vchunk);
        const int xkey = 16 * (wid & 3) + (lane >> 2), xpos = lane & 3;
        xsrc = (const char*)(KRB + ((size_t)b * SEQ + xkey) * 32 + 8 * (xpos ^ ((xkey >> 2) & 3))); tstepK = (size_t)64 * UPO_LD * 2; tstepX = 64 * 32 * 2; }
    else { const bf16_t* rowp = PROJ + ((size_t)b * SEQ + dkey) * D_INP + 64 * h; ksrc = (const char*)(rowp + PC_KA + 8 * kchunk); vsrc = (const char*)(rowp + PC_VA + 8 * vchunk);
        xsrc = (const char*)(MASK + mrow * 32); tstepK = (size_t)64 * D_INP * 2; tstepX = 8; }
    const unsigned wbase = (unsigned)wid * 1024u;
#define A_DMA(t) do { const int t_ = (t); const unsigned so_ = (unsigned)(t_ & 3) * SLOTB; \
        __builtin_amdgcn_global_load_lds((const unsigned*)(ksrc + (size_t)t_ * tstepK), (LAS unsigned*)(lds + so_ + wbase), 16, 0, 0); \
        __builtin_amdgcn_global_load_lds((const unsigned*)(vsrc + (size_t)t_ * tstepK), (LAS unsigned*)(lds + so_ + VOFF + wbase), 16, 0, 0); \
        if constexpr (MLA) { if (wid < 4) __builtin_amdgcn_global_load_lds((const unsigned*)(xsrc + (size_t)t_ * tstepX), (LAS unsigned*)(lds + so_ + XOFF + wbase), 16, 0, 0); } \
        else { __builtin_amdgcn_global_load_lds((const unsigned*)(xsrc + (size_t)t_ * tstepX), (LAS unsigned*)(lds + so_ + XOFF + (unsigned)wid * 512u), 4, 0, 0); \
               __builtin_amdgcn_global_load_lds((const unsigned*)(xsrc + (size_t)t_ * tstepX + 4), (LAS unsigned*)(lds + so_ + XOFF + (unsigned)wid * 512u + 256u), 4, 0, 0); } } while (0)
#define A_WAITBAR(n_) do { if constexpr (!MLA) { if ((n_) == 2) asm volatile("s_waitcnt vmcnt(8)" ::: "memory"); else if ((n_) == 1) asm volatile("s_waitcnt vmcnt(4)" ::: "memory"); else asm volatile("s_waitcnt vmcnt(0)" ::: "memory"); } \
        else if (wid < 4) { if ((n_) == 2) asm volatile("s_waitcnt vmcnt(6)" ::: "memory"); else if ((n_) == 1) asm volatile("s_waitcnt vmcnt(3)" ::: "memory"); else asm volatile("s_waitcnt vmcnt(0)" ::: "memory"); } \
        else { if ((n_) == 2) asm volatile("s_waitcnt vmcnt(4)" ::: "memory"); else if ((n_) == 1) asm volatile("s_waitcnt vmcnt(2)" ::: "memory"); else asm volatile("s_waitcnt vmcnt(0)" ::: "memory"); } \
        __builtin_amdgcn_s_barrier(); asm volatile("" ::: "memory"); } while (0)
    A_DMA(0); A_DMA(1);
    bf16x8 qr[NKS];
    {
        const bf16_t* qrow = MLA ? UPO + mrow * UPO_LD + 96 * h : PROJ + mrow * D_INP + PC_QA + 64 * h;
        u32x4 wq[4], w1 = {0u, 0u, 0u, 0u}, w2 = {0u, 0u, 0u, 0u}; f32x4 c0 = {}, c1 = {}, s0 = {}, s1 = {};
#pragma unroll
        for (int j = 0; j < 4; ++j) wq[j] = *(const u32x4*)(qrow + 16 * j + 8 * hi);
        if constexpr (MLA) { w1 = *(const u32x4*)(qrow + 64 + 8 * hi); w2 = *(const u32x4*)(qrow + 80 + 8 * hi);
            const float* rp = ROPE + mrow * 32 + 8 * hi; c0 = *(const f32x4*)(rp); c1 = *(const f32x4*)(rp + 4); s0 = *(const f32x4*)(rp + 16); s1 = *(const f32x4*)(rp + 20); }
        float c15v = 0.f, lutv = 0.f;
        if constexpr (!MLA) { c15v = rel_bias[15 * 8 + h];
            if (tid < 255) { const int rel = tid - 191; const int n = rel < 0 ? -rel : rel;
                int bk = n < 8 ? n : (n < 12 ? 8 : (n < 16 ? 9 : (n < 23 ? 10 : (n < 32 ? 11 : (n < 46 ? 12 : (n < 64 ? 13 : (n < 91 ? 14 : 15)))))));
                if (rel > 0) bk += 16;
                lutv = rel_bias[bk * 8 + h]; } }
        asm volatile("s_waitcnt vmcnt(0)" ::: "memory");
#pragma unroll
        for (int j = 0; j < 4; ++j) { const u32x4 w = wq[j]; u32x4 o;
            o.x = cvtpk(bflo(w.x) * cs, bfhi(w.x) * cs); o.y = cvtpk(bflo(w.y) * cs, bfhi(w.y) * cs); o.z = cvtpk(bflo(w.z) * cs, bfhi(w.z) * cs); o.w = cvtpk(bflo(w.w) * cs, bfhi(w.w) * cs);
            qr[j] = __builtin_bit_cast(bf16x8, o); }
        if constexpr (MLA) {
            float x1[8] = {bflo(w1.x), bfhi(w1.x), bflo(w1.y), bfhi(w1.y), bflo(w1.z), bfhi(w1.z), bflo(w1.w), bfhi(w1.w)};
            float x2[8] = {bflo(w2.x), bfhi(w2.x), bflo(w2.y), bfhi(w2.y), bflo(w2.z), bfhi(w2.z), bflo(w2.w), bfhi(w2.w)};
            float y1[8], y2[8];
#pragma unroll
            for (int e = 0; e < 8; ++e) { const float cc = e < 4 ? c0[e & 3] : c1[e & 3], ss = e < 4 ? s0[e & 3] : s1[e & 3];
                y1[e] = (x1[e] * cc - x2[e] * ss) * cs; y2[e] = (x2[e] * cc + x1[e] * ss) * cs; }
            u32x4 o1, o2; o1.x = cvtpk(y1[0], y1[1]); o1.y = cvtpk(y1[2], y1[3]); o1.z = cvtpk(y1[4], y1[5]); o1.w = cvtpk(y1[6], y1[7]);
            o2.x = cvtpk(y2[0], y2[1]); o2.y = cvtpk(y2[2], y2[3]); o2.z = cvtpk(y2[4], y2[5]); o2.w = cvtpk(y2[6], y2[7]);
            qr[4] = __builtin_bit_cast(bf16x8, o1); qr[5] = __builtin_bit_cast(bf16x8, o2);
        } else {
            if (tid < 255) ((LAS float*)(lds + LUTOFF))[tid] = lutv * LOG2E;
        }
        c15v *= LOG2E;
        float mrun = -1e30f, lrun = 0.f; f32x16 o0 = {}, o1 = {};
        int kfo[NKS];
#pragma unroll
        for (int j = 0; j < NKS; ++j) kfo[j] = (MLA && j >= 4) ? XOFF + r32 * 64 + (((2 * (j - 4) + hi) ^ ((r32 >> 2) & 3)) << 4) : r32 * 128 + (((2 * j + hi) ^ ((r32 >> 1) & 7)) << 4);
        const int vq = (lane & 15) >> 2, vf = ((vq >> 1) & 1) << 2;
        const int vfo0 = VOFF + (4 * hi + vq) * 128 + ((0 ^ vf) << 4) + ((lane >> 4) & 1) * 32 + (lane & 3) * 8;
        const int vfo1 = VOFF + (4 * hi + vq) * 128 + ((4 ^ vf) << 4) + ((lane >> 4) & 1) * 32 + (lane & 3) * 8;
        for (int t = 0; t < NT; ++t) {
            if (t + 2 < NT) { A_DMA(t + 2); A_WAITBAR(2); } else if (t + 1 < NT) { A_WAITBAR(1); } else { A_WAITBAR(0); }
            if (t <= tmax) {
                const LAS unsigned char* sl = lds + (t & 3) * SLOTB;
                f32x16 s0v, s1v;
                if constexpr (!MLA) {
                    if (64 * t > qw - 154) { const LAS float* lut = (const LAS float*)(lds + LUTOFF); const int base = 64 * t - qglob + 191 + 4 * hi;
#pragma unroll
                        for (int r = 0; r < 16; ++r) { const int o = base + (r & 3) + 8 * (r >> 2); s0v[r] = lut[o]; s1v[r] = lut[o + 32]; } }
                    else {
#pragma unroll
                        for (int r = 0; r < 16; ++r) { s0v[r] = c15v; s1v[r] = c15v; } }
                } else {
#pragma unroll
                    for (int r = 0; r < 16; ++r) { s0v[r] = 0.f; s1v[r] = 0.f; }
                }
                bf16x8 kfa[NKS], kfb[NKS];
#pragma unroll
                for (int j = 0; j < NKS; ++j) { kfa[j] = *(const LAS bf16x8*)(sl + kfo[j]); kfb[j] = *(const LAS bf16x8*)(sl + kfo[j] + ((MLA && j >= 4) ? 2048 : 4096)); }
                __builtin_amdgcn_sched_barrier(0);
#pragma unroll
                for (int j = 0; j < NKS; ++j) { s0v = __builtin_amdgcn_mfma_f32_32x32x16_bf16(kfa[j], qr[j], s0v, 0, 0, 0); s1v = __builtin_amdgcn_mfma_f32_32x32x16_bf16(kfb[j], qr[j], s1v, 0, 0, 0); }
                s16x4 vlo[8], vhi[8]; { const unsigned va0_ = (unsigned)(size_t)(sl + vfo0), va1_ = (unsigned)(size_t)(sl + vfo1);
#pragma unroll
                    for (int i = 0; i < 4; ++i) { asm volatile("ds_read_b64_tr_b16 %0, %1 offset:%2" : "=&v"(vlo[i]) : "v"(va0_), "n"(i * 2048) : "memory");
                        asm volatile("ds_read_b64_tr_b16 %0, %1 offset:%2" : "=&v"(vhi[i]) : "v"(va0_), "n"(i * 2048 + 1024) : "memory");
                        asm volatile("ds_read_b64_tr_b16 %0, %1 offset:%2" : "=&v"(vlo[4 + i]) : "v"(va1_), "n"(i * 2048) : "memory");
                        asm volatile("ds_read_b64_tr_b16 %0, %1 offset:%2" : "=&v"(vhi[4 + i]) : "v"(va1_), "n"(i * 2048 + 1024) : "memory"); } }
                if constexpr (!MLA) { const LAS unsigned* mw = (const LAS unsigned*)(sl + XOFF + wid * 512 + r32 * 4);
                    const unsigned wl = mw[0] >> (4 * hi), wh = mw[64] >> (4 * hi);
#pragma unroll
                    for (int r = 0; r < 16; ++r) { const int bit = (r & 3) + 8 * (r >> 2);
                        const unsigned t0 = (unsigned)__builtin_amdgcn_sbfe((int)wl, bit, 1), t1 = (unsigned)__builtin_amdgcn_sbfe((int)wh, bit, 1);
                        s0v[r] = __uint_as_float((__float_as_uint(s0v[r]) & t0) | (0xff800000u & ~t0)); s1v[r] = __uint_as_float((__float_as_uint(s1v[r]) & t1) | (0xff800000u & ~t1)); } }
                float mx = fmaxf(s0v[0], s1v[0]);
#pragma unroll
                for (int r = 1; r < 16; ++r) mx = fmaxf(mx, fmaxf(s0v[r], s1v[r]));
                mx = xor32_max(mx);
                if (__builtin_amdgcn_ballot_w64(mx > mrun) != 0ull) {
                    const float mnew = fmaxf(mrun, mx); const float alpha = __builtin_amdgcn_exp2f(mrun - mnew); mrun = mnew; lrun *= alpha;
#pragma unroll
                    for (int r = 0; r < 16; ++r) { o0[r] *= alpha; o1[r] *= alpha; } }
                float ls = 0.f;
#pragma unroll
                for (int r = 0; r < 16; ++r) { s0v[r] = __builtin_amdgcn_exp2f(s0v[r] - mrun); s1v[r] = __builtin_amdgcn_exp2f(s1v[r] - mrun); ls += s0v[r] + s1v[r]; }
                lrun += ls;
                bf16x8 pf[4];
                { u32x4 w;
                  w.x = cvtpk(s0v[0], s0v[1]); w.y = cvtpk(s0v[2], s0v[3]); w.z = cvtpk(s0v[4], s0v[5]); w.w = cvtpk(s0v[6], s0v[7]); pf[0] = __builtin_bit_cast(bf16x8, w);
                  w.x = cvtpk(s0v[8], s0v[9]); w.y = cvtpk(s0v[10], s0v[11]); w.z = cvtpk(s0v[12], s0v[13]); w.w = cvtpk(s0v[14], s0v[15]); pf[1] = __builtin_bit_cast(bf16x8, w);
                  w.x = cvtpk(s1v[0], s1v[1]); w.y = cvtpk(s1v[2], s1v[3]); w.z = cvtpk(s1v[4], s1v[5]); w.w = cvtpk(s1v[6], s1v[7]); pf[2] = __builtin_bit_cast(bf16x8, w);
                  w.x = cvtpk(s1v[8], s1v[9]); w.y = cvtpk(s1v[10], s1v[11]); w.z = cvtpk(s1v[12], s1v[13]); w.w = cvtpk(s1v[14], s1v[15]); pf[3] = __builtin_bit_cast(bf16x8, w); }
                asm volatile("s_waitcnt lgkmcnt(0)" : "+v"(vlo[0]), "+v"(vlo[1]), "+v"(vlo[2]), "+v"(vlo[3]), "+v"(vlo[4]), "+v"(vlo[5]), "+v"(vlo[6]), "+v"(vlo[7]),
                             "+v"(vhi[0]), "+v"(vhi[1]), "+v"(vhi[2]), "+v"(vhi[3]), "+v"(vhi[4]), "+v"(vhi[5]), "+v"(vhi[6]), "+v"(vhi[7]) :: "memory");
#pragma unroll
                for (int ks = 0; ks < 4; ++ks) {
                    const bf16x8 va = __builtin_shufflevector(vlo[ks], vhi[ks], 0, 1, 2, 3, 4, 5, 6, 7), vb = __builtin_shufflevector(vlo[4 + ks], vhi[4 + ks], 0, 1, 2, 3, 4, 5, 6, 7);
                    o0 = __builtin_amdgcn_mfma_f32_32x32x16_bf16(va, pf[ks], o0, 0, 0, 0);
                    o1 = __builtin_amdgcn_mfma_f32_32x32x16_bf16(vb, pf[ks], o1, 0, 0, 0);
                }
            }
        }
        lrun = xor32_sum(lrun);
        const float inv = 1.0f / lrun;
        unsigned char* yrow = (unsigned char*)YB + mrow * DM + (MLA ? 512 : 0) + 64 * h + 4 * hi;
        const float ys = inv * Y_SCALE;
#pragma unroll
        for (int g = 0; g < 4; ++g) {
            *(unsigned*)(yrow + 8 * g) = pk4_fp8(o0[4 * g] * ys, o0[4 * g + 1] * ys, o0[4 * g + 2] * ys, o0[4 * g + 3] * ys);
            *(unsigned*)(yrow + 32 + 8 * g) = pk4_fp8(o1[4 * g] * ys, o1[4 * g + 1] * ys, o1[4 * g + 2] * ys, o1[4 * g + 3] * ys); }
    }
    asm volatile("s_waitcnt vmcnt(0) lgkmcnt(0)" ::: "memory"); __builtin_amdgcn_s_barrier(); asm volatile("" ::: "memory");
#undef A_DMA
#undef A_WAITBAR
}
DI void phase_attention(KP p, const Ctx& c) {
    for (int v = c.vcu; v < 256; v += c.G) { const int bh = v >> 2, s = v & 3, b = bh >> 3, h = bh & 7;
        for (int rep_ = 0; rep_ < (PROBE_X == 4 ? 2 : 1); ++rep_) attn_unit<false>(c, p->rel_bias, b, h, 7 - s);
        for (int rep_ = 0; rep_ < (PROBE_X == 5 ? 2 : 1); ++rep_) attn_unit<true>(c, p->rel_bias, b, h, 7 - s);
        for (int rep_ = 0; rep_ < (PROBE_X == 4 ? 2 : 1); ++rep_) attn_unit<false>(c, p->rel_bias, b, h, s);
        for (int rep_ = 0; rep_ < (PROBE_X == 5 ? 2 : 1); ++rep_) attn_unit<true>(c, p->rel_bias, b, h, s); }
}

DI void phase_router(KP p, const Ctx& c, int layer) {
    const bf16_t* XR = (const bf16_t*)(c.ws + WS_XR); unsigned char* HB8 = c.ws + WS_XP8; const float* MODS = (const float*)(c.ws + WS_MODS);
    int* ME = (int*)(c.ws + WS_ME); int* MR = (int*)(c.ws + WS_MR); float* MG = (float*)(c.ws + WS_MG);
    unsigned* gcnt = (unsigned*)(c.ws + WS_CTL) + CW_GCNT + layer * 64;
    constexpr int HS_LD = 1025;
    LAS float* hs = (LAS float*)c.lds;
    LAS float* red = (LAS float*)c.lds;
    LAS float* logit = (LAS float*)(c.lds + 34816);
    LAS int* lcnt = (LAS int*)(c.lds + LC_MISC);
    const float* wr_ = p->w_router + (size_t)layer * 1024 * 32; const float* br_ = p->b_router + layer * 32;
    const int r32 = c.lane & 31, hi = c.lane >> 5;
    float wv[64];
#pragma unroll
    for (int kk = 0; kk < 64; ++kk) wv[kk] = wr_[(c.wave * 128 + 2 * kk + hi) * 32 + r32];
    for (int blk = c.vcu; blk < NTOK / 64; blk += c.G) {
        if (c.tid < 32) lcnt[c.tid] = 0;
        __syncthreads();
        for (int grp = 0; grp < 2; ++grp) {
            const int m0 = blk * 64 + grp * 32;
            { f32x4 v[4][4];
#pragma unroll
              for (int i = 0; i < 4; ++i) load_row_bf(XR + (size_t)(m0 + c.wave * 4 + i) * DM, c.lane, v[i]);
#pragma unroll
              for (int i = 0; i < 4; ++i) { const int tl = c.wave * 4 + i, m = m0 + tl, b = m >> 11; f32x4 h[4];
                const float r = row_rinv(v[i], c.lane);
                const float* md = MODS + (layer * 8 + b) * 6144 + 3 * 1024;
                modulate(v[i], r, p->norm_ffn + layer * 1024, md, md + 1024, c.lane, h);
#pragma unroll
                for (int j = 0; j < 4; ++j) *(unsigned*)(HB8 + (size_t)m * DM + 4 * c.lane + 256 * j) = pk4_fp8(h[j][0] * X_SCALE, h[j][1] * X_SCALE, h[j][2] * X_SCALE, h[j][3] * X_SCALE);
#pragma unroll
                for (int j = 0; j < 4; ++j)
#pragma unroll
                    for (int e = 0; e < 4; ++e) hs[tl * HS_LD + 4 * c.lane + 256 * j + e] = h[j][e]; } }
            __syncthreads();
            f32x16 acc = {};
#pragma unroll
            for (int kk = 0; kk < 64; ++kk) { const int k = c.wave * 128 + 2 * kk + hi;
                acc = __builtin_amdgcn_mfma_f32_32x32x2f32(hs[r32 * HS_LD + k], wv[kk], acc, 0, 0, 0); }
            __syncthreads();
#pragma unroll
            for (int r = 0; r < 16; ++r) red[(c.wave * 32 + crow(r, hi)) * 33 + r32] = acc[r];
            __syncthreads();
            for (int i = c.tid; i < 1024; i += 512) { const int tk = i >> 5, e = i & 31; float s = br_[e];
#pragma unroll
                for (int w = 0; w < 8; ++w) s += red[(w * 32 + tk) * 33 + e];
                logit[tk * 33 + e] = s; }
            __syncthreads();
            if (c.tid < 32) { const int m = m0 + c.tid; const LAS float* lg = logit + c.tid * 33; float tv[4]; int te[4]; float x[32];
#pragma unroll
                for (int e = 0; e < 32; ++e) x[e] = lg[e];
#pragma unroll
                for (int k = 0; k < 4; ++k) { float best = x[0]; int be = 0;
#pragma unroll
                    for (int e = 1; e < 32; ++e) { if (x[e] > best) { best = x[e]; be = e; } }
#pragma unroll
                    for (int e = 0; e < 32; ++e) x[e] = (e == be) ? -INFINITY : x[e];
                    tv[k] = best; te[k] = be; }
                float gs = 0.f, gv[4];
#pragma unroll
                for (int k = 0; k < 4; ++k) { gv[k] = __expf(tv[k] - tv[0]); gs += gv[k]; }
#pragma unroll
                for (int k = 0; k < 4; ++k) { ME[m * 4 + k] = te[k]; MG[m * 4 + k] = gv[k] / gs; MR[m * 4 + k] = atomicAdd((int*)&lcnt[te[k]], 1); } }
            __syncthreads();
        }
        if (c.tid < 32) lcnt[32 + c.tid] = (int)atomicAdd(&gcnt[c.tid], (unsigned)lcnt[c.tid]);
        __syncthreads();
        if (c.tid < 256) { const int m = blk * 64 + (c.tid >> 2), k = c.tid & 3; const int e = ME[m * 4 + k]; const int rk = MR[m * 4 + k] + lcnt[32 + e]; MR[m * 4 + k] = rk; ((int*)(c.ws + WS_RANKTOK))[e * 16384 + rk] = m; }
        __syncthreads();
    }
}
constexpr int NPHASE = 20;
DI void refresh(Ctx& c, KP& p) {
    asm volatile("" : "+s"(p));
    int w_id = c.wave, z_ = 0; asm volatile("" : "+s"(w_id), "+v"(z_));
    c.wave = w_id; c.lane = (int)__builtin_amdgcn_mbcnt_hi(~0u, __builtin_amdgcn_mbcnt_lo(~0u, (unsigned)z_)); c.tid = w_id * 64 + c.lane;
    int g_ = gridDim.x, b_ = blockIdx.x; asm volatile("" : "+s"(g_), "+s"(b_)); c.G = g_; c.bx = b_;
    c.vcu = (g_ % 8 == 0) ? (b_ % 8) * (g_ / 8) + b_ / 8 : b_;
    c.gw = c.vcu * 8 + c.wave; c.NGW = g_ * 8;
    if (g_ == 256) { c.rbase = (c.vcu >> 5) * SEQ; c.rcnt = SEQ; c.lw = (c.vcu & 31) * 8 + c.wave; c.NLW = 256; } else { c.rbase = 0; c.rcnt = NTOK; c.lw = c.gw; c.NLW = c.NGW; }
    unsigned char* w_ = p->ws; asm volatile("" : "+s"(w_)); c.ws = w_;
    unsigned l_ = 0u; asm volatile("" : "+s"(l_)); c.lds = (LAS unsigned char*)(uintptr_t)l_;
}
template <int PH> DI void run_phase(KP p, const Ctx& c) {
    if constexpr (PH == 0) phase_prologue(p, c);
    else if constexpr (PH == NPHASE - 1) phase_final(p, c);
    else {
        constexpr int layer = (PH - 1) / 9, sub = (PH - 1) % 9;
        if constexpr (sub == 0) phase_norm_mix(p, c, layer);
        else if constexpr (sub == 1) {
            { SchedDense S{(const char*)(c.ws + WS_HBUF), (const char*)(c.ws + WS_WIN) + ((size_t)layer * D_INP + PC_QI) * 1024 * 2, NTOK / 256, (D_INP - PC_QI) / 256, c.G, c.bx, (size_t)256 * 1024 * 2};
              EpiProj E{(bf16_t*)(c.ws + WS_PROJ) + PC_QI, D_INP, 1.0f}; pg8::gemm_phase<false, false>(c.lds, c.tid, 1024, S, E); }
            { SchedDense S{(const char*)(c.ws + WS_H8IN), (const char*)(c.ws + WS_WIN8) + (size_t)layer * PC_QI * 1024, NTOK / 256, PC_QI / 256, c.G, c.bx, (size_t)256 * 1024, layer != 0};
              EpiProj E{(bf16_t*)(c.ws + WS_PROJ), D_INP, 1.0f / (X_SCALE * W_SCALE)}; pg8::gemm_phase<true, false>(c.lds, c.tid, 512, S, E); }
            if constexpr (layer == 0) {
                if (c.bx >= 128) { __syncthreads(); big_convert(p, c, c.bx - 128, 128, SLOT_IN, BIG_ND, 0, BIG_L1); } } }
        else if constexpr (sub == 2) phase_prep_indexer(p, c, layer);
        else if constexpr (sub == 3) { SchedUp S{(const char*)(c.ws + WS_CQN), (const char*)(c.ws + WS_WUP) + (size_t)layer * 1792 * 256 * 2, c.G, c.bx};
            EpiProj E{(bf16_t*)(c.ws + WS_UPO), UPO_LD, 1.0f}; pg8::gemm_phase<false, false>(c.lds, c.tid, 256, S, E); }
        else if constexpr (sub == 4) phase_attention(p, c);
        else if constexpr (sub == 5) { SchedDense S{(const char*)(c.ws + WS_YBUF), (const char*)(c.ws + WS_WOUT) + (size_t)layer * 1024 * 1024, NTOK / 256, 4, c.G, c.bx, (size_t)256 * 1024};
            EpiOut<layer == 0> E{(bf16_t*)(c.ws + WS_XR), p->x, (const float*)(c.ws + WS_MODS) + layer * 8 * 6144 + 2 * 1024, 1.0f / (Y_SCALE * W_SCALE)}; pg8::gemm_phase<true, false>(c.lds, c.tid, 512, S, E); }
        else if constexpr (sub == 6) { phase_router(p, c, layer);
            if constexpr (layer == DEPTH - 1) { __syncthreads(); const int base = *(const LAS int*)(c.lds + LC_DEFER);
                big_convert(p, c, base + c.vcu, c.G, 1 << 20, BIG_ND, 0, BIG_L1); } }
        else if constexpr (sub == 7) {
            const int nt = build_tiles(c, layer);
            const LAS int* pst = (const LAS int*)(c.lds + LC_PST); const LAS int* tile_e = (const LAS int*)(c.lds + LC_TILEE); const LAS int* cnt = (const LAS int*)(c.lds + LC_CNT);
            LAS int* rowtab = (LAS int*)(c.lds + RT_OFF); const int* RANKTOK = (const int*)(c.ws + WS_RANKTOK);
            SchedMoeG S{(const char*)(c.ws + WS_XP8), (const char*)(c.ws + WS_W1) + (size_t)layer * 32 * 2048 * 1024, tile_e, rowtab, nt, 8, c.G, c.bx, layer != 0};
            { int tok[9];
#pragma unroll
              for (int i = 0; i < 9; ++i) { Unit u; tok[i] = -1; if (c.tid < 256 && S.next(i, u)) { const int e = tile_e[u.pm]; const int rk = (u.pm - pst[e]) * 256 + c.tid; tok[i] = rk < cnt[e] ? RANKTOK[e * 16384 + rk] : 0; } }
#pragma unroll
              for (int i = 0; i < 9; ++i) if (tok[i] >= 0) rowtab[i * 256 + c.tid] = tok[i] * 1024; }
            __syncthreads();
            EpiSwiglu E{c.ws + WS_HID8, p->b1 + (size_t)layer * 32 * 2048, tile_e}; pg8::gemm_phase<true, true>(c.lds, c.tid, 512, S, E);
            if constexpr (layer == 0) { const int r1 = (nt * 8) & 255, nid = r1 ? 256 - r1 : 0;
                if (r1 && c.bx >= r1) { __syncthreads(); big_convert(p, c, 128 * SLOT_IN + (c.bx - r1), nid, SLOT_MOE, BIG_ND, 0, BIG_L1); }
                if (c.tid == 0) *(LAS int*)(c.lds + LC_DEFER) = 128 * SLOT_IN + SLOT_MOE * nid; } }
        else { const int nt = reuse_tiles(c, layer);
            SchedMoe S{(const char*)(c.ws + WS_HID8), (const char*)(c.ws + WS_W2) + (size_t)layer * 32 * 1024 * 1024, (const LAS int*)(c.lds + LC_TILEE), nt, 4, c.G, c.bx, layer != 0};
            EpiDown E{c.ws + WS_YEXP, p->b2 + (size_t)layer * 32 * 1024, (const LAS int*)(c.lds + LC_TILEE)}; pg8::gemm_phase<true, false>(c.lds, c.tid, 512, S, E);
            if constexpr (layer == 0) { const int r2 = (nt * 4) & 255, nid = r2 ? 256 - r2 : 0; const int base = *(const LAS int*)(c.lds + LC_DEFER);
                __syncthreads();
                if (r2 && c.bx >= r2) big_convert(p, c, base + (c.bx - r2), nid, SLOT_MOE, BIG_ND, 0, BIG_L1);
                if (c.tid == 0) *(LAS int*)(c.lds + LC_DEFER) = base + SLOT_MOE * nid; } }
    }
}
__global__ void __launch_bounds__(512, 2) fwd_kernel(P p_arg, int ph_lo, int ph_hi) {
    extern __shared__ __attribute__((aligned(16))) unsigned char lds_raw[];
    KP p = (KP)__builtin_amdgcn_kernarg_segment_ptr();
    Ctx c; c.wave = __builtin_amdgcn_readfirstlane((int)threadIdx.x >> 6); refresh(c, p);
    for (int u = c.tid; u < (LDS_BYTES - LC_OFF) / 4; u += 512) ((LAS unsigned*)(c.lds + LC_OFF))[u] = 0u;
    __syncthreads();
#if !MULTI_LAUNCH
    XcdBarrier bar = xcd_barrier_post((unsigned*)(c.ws + WS_CTL) + CW_BAR, (volatile LAS unsigned*)(c.lds + LC_BARST), c.tid);
    if (c.tid == 0 && (bar.x != (unsigned)(c.bx & 7) || c.G != 256)) (void)xb_add((unsigned*)(c.ws + WS_CTL) + CW_MISMATCH, 1u);
#define SEAM_LOCAL(k) ((k) >= 1 && (k) < NPHASE - 1 && ((k) - 1) % 9 <= 5)
#define SEAM(k) do { if ((k) + 1 < ph_hi) { xcd_barrier(bar, c.tid, SEAM_LOCAL(k)); \
        if ((k) == 0 && c.tid == 0) bar.st[2] = (xb_ld((unsigned*)(c.ws + WS_CTL) + CW_MISMATCH) == 0u) ? 1u : 0u; } } while (0)
#else
#define SEAM(k) do { } while (0)
#endif
#ifndef DBL_MASK
#define DBL_MASK 0u
#endif
#if MULTI_LAUNCH
#define REDO(k) do { } while (0)
#else
#define REDO(k) do { if constexpr (((DBL_MASK) >> (k)) & 1u) { xcd_barrier(bar, c.tid); refresh(c, p); run_phase<k>(p, c); } } while (0)
#endif
#define RUN(k) do { if (ph_lo <= (k) && (k) < ph_hi) { refresh(c, p); run_phase<k>(p, c); REDO(k); SEAM(k); } } while (0)
    RUN(0); RUN(1); RUN(2); RUN(3); RUN(4); RUN(5); RUN(6); RUN(7); RUN(8); RUN(9); RUN(10);
    RUN(11); RUN(12); RUN(13); RUN(14); RUN(15); RUN(16); RUN(17); RUN(18); RUN(19);
#undef RUN
#undef SEAM
}

extern "C" void kernel_launch(void* const* d_in, const int* in_sizes, int n_in, void* d_out, int out_size, void* d_ws, size_t ws_size, hipStream_t stream) {
    static int ready = 0;
    if (!ready) {
        if (n_in != 21 || ws_size < WS_END || out_size != NTOK * DM) { fprintf(stderr, "kernel_launch: unexpected shapes (n_in %d, ws %zu, out %d)\n", n_in, ws_size, out_size); ready = -1; return; }
        if (hipFuncSetAttribute((const void*)fwd_kernel, hipFuncAttributeMaxDynamicSharedMemorySize, LDS_BYTES) != hipSuccess) { fprintf(stderr, "kernel_launch: hipFuncSetAttribute failed\n"); ready = -1; return; }
        int per_cu = 0; (void)hipOccupancyMaxActiveBlocksPerMultiprocessor(&per_cu, (const void*)fwd_kernel, 512, LDS_BYTES); (void)hipGetLastError();
        if (per_cu < 1) { fprintf(stderr, "kernel_launch: occupancy query says %d workgroups per CU; the grid barrier needs every workgroup resident; nothing launched\n", per_cu); ready = -1; return; }
        ready = 1;
    }
    if (ready < 0) return;
    (void)hipMemsetAsync((char*)d_ws + WS_CTL, 0, CTL_BYTES, stream);
    P p{};
    p.x = (const float*)d_in[0]; p.c = (const float*)d_in[1]; p.pos = (const int*)d_in[2]; p.rel_bias = (const float*)d_in[3]; p.norm_mix = (const float*)d_in[4];
    p.w_ada = (const float*)d_in[5]; p.b_ada = (const float*)d_in[6]; p.w_in = (const float*)d_in[7]; p.q_norm = (const float*)d_in[8]; p.w_uq = (const float*)d_in[9];
    p.kv_norm = (const float*)d_in[10]; p.w_ukv = (const float*)d_in[11]; p.w_out = (const float*)d_in[12]; p.norm_ffn = (const float*)d_in[13]; p.w_router = (const float*)d_in[14];
    p.b_router = (const float*)d_in[15]; p.w1 = (const float*)d_in[16]; p.b1 = (const float*)d_in[17]; p.w2 = (const float*)d_in[18]; p.b2 = (const float*)d_in[19]; p.norm_final = (const float*)d_in[20];
    p.out = (float*)d_out; p.ws = (unsigned char*)d_ws;
#if MULTI_LAUNCH
    for (int ph = 0; ph < NPHASE; ++ph) hipLaunchKernelGGL(fwd_kernel, dim3(256), dim3(512), LDS_BYTES, stream, p, ph, ph + 1);
#else
    int lo = 0, hi = NPHASE; void* args[] = {&p, &lo, &hi};
    hipError_t e = hipLaunchCooperativeKernel((const void*)fwd_kernel, dim3(256), dim3(512), args, LDS_BYTES, stream);
    if (e != hipSuccess) fprintf(stderr, "cooperative launch failed: %s\n", hipGetErrorString(e));
#endif
}
```

```cpp
#include <hip/hip_runtime.h>
#include <hip/hip_cooperative_groups.h>
#include <cstdio>
#include <cstdint>
namespace cg = cooperative_groups;

#ifndef MULTI_LAUNCH
#define MULTI_LAUNCH 0
#endif

#ifndef PROBE_X
#define PROBE_X 0
#endif
#define LAS __attribute__((address_space(3)))
#define DI __device__ __forceinline__
typedef unsigned short bf16_t;
typedef short bf16x8 __attribute__((ext_vector_type(8)));
typedef short s16x4 __attribute__((ext_vector_type(4)));
typedef float f32x2 __attribute__((ext_vector_type(2)));
typedef float f32x4 __attribute__((ext_vector_type(4)));
typedef float f32x16 __attribute__((ext_vector_type(16)));
typedef unsigned u32x2 __attribute__((ext_vector_type(2)));
typedef unsigned u32x4 __attribute__((ext_vector_type(4)));
typedef __bf16 bf16x2_t __attribute__((ext_vector_type(2)));

constexpr int DM = 1024, BATCH = 8, SEQ = 2048, NTOK = BATCH * SEQ, DEPTH = 2;
constexpr int D_IN = 2536, D_INP = 2560;
constexpr int NE = 32, DEXP = 1024;
constexpr int CAP_TILES = 288, CAP_ROWS = CAP_TILES * 256;
constexpr float EPS = 1e-6f;
constexpr float LOG2E = 1.4426950408889634f;
constexpr int PC_QA = 0, PC_KA = 512, PC_VA = 1024, PC_QI = 1536, PC_KI = 2048, PC_CQ = 2112, PC_CKV = 2368, PC_KR = 2496, PC_WI = 2528;

constexpr size_t MiB = 1u << 20;
constexpr size_t WS_CTL = 0, CTL_BYTES = 64 * 1024;
constexpr size_t WS_MODS = 1 * MiB;
constexpr size_t WS_ROPE = 2 * MiB;
constexpr size_t WS_WIN = 4 * MiB;
constexpr size_t WS_WUP = 14 * MiB;
constexpr size_t WS_WOUT = 16 * MiB;
constexpr size_t WS_W1 = 20 * MiB;
constexpr size_t WS_W2 = 276 * MiB;
constexpr size_t WS_HBUF = 404 * MiB;
constexpr size_t WS_PROJ = 436 * MiB;
constexpr size_t WS_CQN = 516 * MiB;
constexpr size_t WS_CKVN = 524 * MiB;
constexpr size_t WS_KR = 532 * MiB;
constexpr size_t WS_UPO = 533 * MiB;
constexpr int UPO_LD = 1792;
constexpr size_t WS_MASK = 589 * MiB;
constexpr size_t WS_YBUF = 593 * MiB;
constexpr size_t WS_XR = 625 * MiB;
constexpr size_t WS_ME = 689 * MiB;
constexpr size_t WS_MR = 690 * MiB;
constexpr size_t WS_MG = 691 * MiB;
constexpr size_t WS_DEST = 692 * MiB;
constexpr size_t WS_YEXP = 693 * MiB;
constexpr size_t WS_XP8 = 837 * MiB;
constexpr size_t WS_WIN8 = 860 * MiB;
constexpr size_t WS_H8IN = 870 * MiB;
constexpr size_t WS_HID8 = 909 * MiB;
constexpr float W_SCALE = 64.f, X_SCALE = 8.f, H_SCALE = 4.f, Y_SCALE = 16.f, YE_SCALE = 16.f;
constexpr size_t WS_RANKTOK = 981 * MiB;
constexpr size_t WS_END = 983 * MiB;
constexpr int CW_GCNT = 64;
constexpr int CW_BAR = 4096;
constexpr int CW_MISMATCH = 32;

constexpr int SCR_BYTES = 133120;
constexpr int LC_OFF = SCR_BYTES;
constexpr int LC_BARST = LC_OFF;
constexpr int LC_PST = LC_OFF + 64;
constexpr int LC_TILEE = LC_OFF + 256;
constexpr int LC_MISC = LC_OFF + 256 + 1280;
constexpr int LC_CNT = LC_OFF + 1792;
constexpr int LC_DEFER = LC_OFF + 2048;
constexpr int SLOT_IN = 3, SLOT_MOE = 2;
constexpr int RT_OFF = SCR_BYTES + 4096;
constexpr int LDS_BYTES = RT_OFF + 9 * 1024;

struct P {
    const float *x, *c; const int* pos; const float *rel_bias, *norm_mix, *w_ada, *b_ada, *w_in, *q_norm, *w_uq, *kv_norm, *w_ukv, *w_out,
        *norm_ffn, *w_router, *b_router, *w1, *b1, *w2, *b2, *norm_final;
    float* out; unsigned char* ws;
};

typedef __attribute__((address_space(4))) const P* KP;

DI unsigned cvtpk(float lo, float hi) { f32x2 v = {lo, hi}; bf16x2_t b = __builtin_convertvector(v, bf16x2_t); return __builtin_bit_cast(unsigned, b); }
DI float clamp8(float x) { return fminf(fmaxf(x, -448.f), 448.f); }
DI unsigned pk4_fp8(float a, float b, float c, float d) { int w = 0; w = __builtin_amdgcn_cvt_pk_fp8_f32(clamp8(a), clamp8(b), w, false); w = __builtin_amdgcn_cvt_pk_fp8_f32(clamp8(c), clamp8(d), w, true); return (unsigned)w; }
DI unsigned pk4_fp8_nc(float a, float b, float c, float d) { int w = 0; w = __builtin_amdgcn_cvt_pk_fp8_f32(a, b, w, false); w = __builtin_amdgcn_cvt_pk_fp8_f32(c, d, w, true); return (unsigned)w; }
DI float bflo(unsigned u) { return __uint_as_float(u << 16); }
DI float bfhi(unsigned u) { return __uint_as_float(u & 0xffff0000u); }
DI float bf1(bf16_t h) { return __uint_as_float((unsigned)h << 16); }
DI float wave_sum(float v, int lane) {
    (void)lane;
    v += __int_as_float(__builtin_amdgcn_update_dpp(__float_as_int(v), __float_as_int(v), 0xB1, 0xF, 0xF, false));
    v += __int_as_float(__builtin_amdgcn_update_dpp(__float_as_int(v), __float_as_int(v), 0x4E, 0xF, 0xF, false));
    v += __int_as_float(__builtin_amdgcn_update_dpp(__float_as_int(v), __float_as_int(v), 0x141, 0xF, 0xF, false));
    v += __int_as_float(__builtin_amdgcn_update_dpp(__float_as_int(v), __float_as_int(v), 0x140, 0xF, 0xF, false));
    return (__int_as_float(__builtin_amdgcn_readlane(__float_as_int(v), 0)) + __int_as_float(__builtin_amdgcn_readlane(__float_as_int(v), 16)))
         + (__int_as_float(__builtin_amdgcn_readlane(__float_as_int(v), 32)) + __int_as_float(__builtin_amdgcn_readlane(__float_as_int(v), 48)));
}
DI float xor32_max(float m) { auto rr = __builtin_amdgcn_permlane32_swap(__float_as_uint(m), __float_as_uint(m), false, false); return fmaxf(__uint_as_float(rr[0]), __uint_as_float(rr[1])); }
DI float xor32_sum(float m) { auto rr = __builtin_amdgcn_permlane32_swap(__float_as_uint(m), __float_as_uint(m), false, false); return __uint_as_float(rr[0]) + __uint_as_float(rr[1]); }
DI int crow(int r, int hi) { return (r & 3) + 8 * (r >> 2) + 4 * hi; }
#define LDS_WAIT() asm volatile("s_waitcnt lgkmcnt(0)" ::: "memory")
#define VM_WAIT() asm volatile("s_waitcnt vmcnt(0)" ::: "memory")

struct Ctx {
    LAS unsigned char* lds;
    int tid, lane, wave, G, vcu, gw, NGW, bx;
    int rbase, rcnt, lw, NLW;
    unsigned char* ws;
};

#define XB_TMO      128
#define XB_XCNT(j)  (256  + 64 * (j))
#define XB_XSUB(j)  (1280 + 64 * (j))
#define XB_XGEN(j)  (2304 + 64 * (j))
#define XB_TOP      3328
#define XB_TOPGEN   3392
#define XCD_BAR_WORDS 3456
#define XB_SPIN_CAP (1u << 22)
DI unsigned xb_ld(unsigned* p) { return __hip_atomic_load(p, __ATOMIC_RELAXED, __HIP_MEMORY_SCOPE_AGENT); }
DI unsigned xb_add(unsigned* p, unsigned v) { return __hip_atomic_fetch_add(p, v, __ATOMIC_RELAXED, __HIP_MEMORY_SCOPE_AGENT); }
DI unsigned xb_xcc_id() { return (unsigned)__builtin_amdgcn_s_getreg((3 << 11) | 20) & 0xFu; }
#define XB_SPIN(cond, bar) do { unsigned _sp = 0; while (cond) { __builtin_amdgcn_s_sleep(1); \
    if ((++_sp & 255u) == 0u) { if (xb_ld(&(bar)[XB_TMO])) break; if (_sp > XB_SPIN_CAP) { atomicAdd(&(bar)[XB_TMO], 1u); break; } } } } while (0)
struct XcdBarrier { unsigned* bar; unsigned x; volatile LAS unsigned* st; };
DI XcdBarrier xcd_barrier_post(unsigned* bar, volatile LAS unsigned* st, int tid) {
    XcdBarrier b; b.bar = bar; b.x = xb_xcc_id(); b.st = st;
    if (tid == 0) (void)xb_add(&bar[XB_XCNT(b.x)], 1u);
    return b;
}
DI void xcd_barrier_complete(unsigned* bar, unsigned x, unsigned& nloc, unsigned& nx) {
    const unsigned G = gridDim.x * gridDim.y * gridDim.z;
    unsigned sum, cnt, mine, sp = 0u;
    for (;;) {
        sum = 0u; cnt = 0u; mine = 0u;
#pragma unroll
        for (unsigned j = 0; j < 16; ++j) { const unsigned c = xb_ld(&bar[XB_XCNT(j)]); sum += c; cnt += (c > 0u) ? 1u : 0u; mine = (j == x) ? c : mine; }
        if (sum == G) break;
        __builtin_amdgcn_s_sleep(1);
        if ((++sp & 255u) == 0u) { if (xb_ld(&bar[XB_TMO])) break; if (sp > XB_SPIN_CAP) { atomicAdd(&bar[XB_TMO], 1u); break; } }
    }
    nloc = mine > 0u ? mine : 1u; nx = cnt > 0u ? cnt : 1u;
}
DI void xcd_barrier(const XcdBarrier& b, int tid, const bool local_seam = false) {
    asm volatile("s_waitcnt vmcnt(0)" ::: "memory");
    __syncthreads();
    if (tid == 0) {
        unsigned* bar = b.bar;
        __builtin_amdgcn_s_waitcnt(0);
        unsigned nloc = b.st[0], nx = b.st[1];
        if (nloc == 0u) { xcd_barrier_complete(bar, b.x, nloc, nx); b.st[0] = nloc; b.st[1] = nx; }
        const bool loc = local_seam && b.st[2] != 0u;
        if (loc) __builtin_amdgcn_fence(__ATOMIC_ACQUIRE, "agent");
        const unsigned old = xb_add(&bar[XB_XSUB(b.x)], 1u);
        const unsigned gen = old / nloc;
        if (loc) {
            if (old + 1u == (gen + 1u) * nloc) xb_add(&bar[XB_XGEN(b.x)], 1u);
            else XB_SPIN(xb_ld(&bar[XB_XGEN(b.x)]) == gen, bar);
            asm volatile("s_waitcnt vmcnt(0)" ::: "memory");
        } else if (old + 1u == (gen + 1u) * nloc) {
            __builtin_amdgcn_fence(__ATOMIC_RELEASE, "agent");
            asm volatile("s_waitcnt vmcnt(0)" ::: "memory");
            const unsigned og = xb_add(&bar[XB_TOP], 1u);
            const unsigned tg = og / nx;
            if (og + 1u == (tg + 1u) * nx) xb_add(&bar[XB_TOPGEN], 1u);
            else XB_SPIN(xb_ld(&bar[XB_TOPGEN]) == tg, bar);
            __builtin_amdgcn_fence(__ATOMIC_ACQUIRE, "agent");
            xb_add(&bar[XB_XGEN(b.x)], 1u);
            asm volatile("s_waitcnt vmcnt(0)" ::: "memory");
        } else {
            XB_SPIN(xb_ld(&bar[XB_XGEN(b.x)]) == gen, bar);
            __builtin_amdgcn_fence(__ATOMIC_ACQUIRE, "agent");
            asm volatile("s_waitcnt vmcnt(0)" ::: "memory");
        }
    }
    __syncthreads();
}

namespace pg8 {
constexpr int BM = 256, BK = 64, HALF = 128, HTB = HALF * BK * 2, NXCD = 8, WGM = 8;
DI int lds_byte(int r, int c) { const int st = (r >> 4) * 2 + (c >> 5), rr = r & 15, cc = c & 31, ob = rr * 64 + cc * 2; return st * 1024 + (ob ^ (((ob >> 9) & 1) << 5)); }
DI void stage_rc(int b, int& R, int& C) { const int st = b / 1024, sb = b % 1024, swz = sb ^ (((sb >> 9) & 1) << 5); R = (st >> 1) * 16 + swz / 64; C = (st & 1) * 32 + (swz % 64) / 2; }
DI int f8_swz(int r) { return ((r >> 1) & 7) ^ ((((r >> 2) ^ (r >> 3)) & 1) << 1); }
DI int lds_byte_f8(int r, int chunk) { return r * 128 + ((chunk ^ f8_swz(r & 15)) << 4); }
DI void stage_rc_f8(int b, int& R, int& C) { R = b >> 7; C = (((b >> 4) & 7) ^ f8_swz(R & 15)) << 3; }
DI int perm32(int rho) { const int n = rho >> 4, i = rho & 15; return 8 * (i >> 2) + 4 * n + (i & 3); }
struct Unit { int pm, pn, half; };
DI bool order_next(int i, int G, int c, int nM, int nN, Unit& u, const int WGM = 8, const bool split = false) {
    const int nwg = nM * nN; long L = (long)i * G + c; u.half = 0;
    if (split && G == 256) { const int F = nwg >> 8, R = nwg & 255;
        if (i == F && R > 0 && R <= 128) { const int t = (c & 7) + 8 * (c >> 4); if (t >= R) return false; L = (long)F * 256 + t; u.half = 1 + ((c >> 3) & 1); } }
    if (L >= nwg) return false;
    int wgid = (int)L; { const int q = nwg / NXCD, r = nwg % NXCD, xcd = wgid % NXCD, off = wgid / NXCD; wgid = (xcd < r ? xcd * (q + 1) : r * (q + 1) + (xcd - r) * q) + off; }
    const int nig = WGM * nN, gid = wgid / nig, fm = gid * WGM, gsz = (nM - fm) < WGM ? (nM - fm) : WGM;
    u.pm = fm + ((wgid % nig) % gsz); u.pn = (wgid % nig) / gsz; return true;
}
DI void moe_chunk(int nM, int x, int& start, int& ntx) { const int base = nM >> 3, rem = nM & 7; ntx = base + (x < rem ? 1 : 0); start = x * base + (x < rem ? x : rem); }
DI bool order_moe(int i, int c, int nM, int nN, Unit& u, const int WGM, const bool split) {
    const int x = c & 7, r = c >> 3; int start, ntx; moe_chunk(nM, x, start, ntx);
    const int nwg = ntx * nN; int L = i * 32 + r; u.half = 0;
    if (split) { const int F = nwg >> 5, R = nwg & 31;
        if (i == F && R > 0 && R <= 16) { const int t = r >> 1; if (t >= R) return false; L = F * 32 + t; u.half = 1 + (r & 1); } }
    if (L >= nwg) return false;
    const int nig = WGM * nN, gid = L / nig, fm = gid * WGM, gsz = (ntx - fm) < WGM ? (ntx - fm) : WGM;
    u.pm = start + fm + ((L % nig) % gsz); u.pn = (L % nig) / gsz; return true;
}
DI void moe_idle(int nM, int nN, int x, int& rx, int& nid_x, int& before, int& total) {
    before = 0; total = 0; rx = 0; nid_x = 0;
#pragma unroll
    for (int y = 0; y < 8; ++y) { int st, nty; moe_chunk(nM, y, st, nty); const int ry = (nty * nN) & 31, ny = ry ? 32 - ry : 0; if (y < x) before += ny; if (y == x) { rx = ry; nid_x = ny; } total += ny; }
}
typedef int v8i32 __attribute__((ext_vector_type(8)));
template <bool F8, bool GATHER, class Epi, class Sched>
DI void gemm_phase(LAS unsigned char* lds, const int tid, const int K, const Sched& S, const Epi& E) {
    const int wid = __builtin_amdgcn_readfirstlane(tid >> 6), lane = tid & 63, wr = wid >> 2, wc = wid & 3, fr = lane & 15, fq = lane >> 4;
    int nt = K / BK; asm volatile("" : "+s"(nt));
    unsigned voffA[2], voffB[2]; int rowA[2];
#pragma unroll
    for (int i = 0; i < 2; ++i) { int R, C; if constexpr (F8) stage_rc_f8(tid * 16 + i * 8192, R, C); else stage_rc(tid * 16 + i * 8192, R, C); const int Rb = Epi::PERM ? ((R & ~31) + perm32(R & 31)) : R;
        voffA[i] = GATHER ? (unsigned)C * 2u : (unsigned)(R * K + C) * 2u; voffB[i] = (unsigned)(Rb * K + C) * 2u; rowA[i] = R; }
    unsigned va[2][2], vn[2][2];
#define PG8_ROWS(dst, ui_) do { if constexpr (GATHER) { const LAS int* rt_ = S.rowtab(ui_); _Pragma("unroll") for (int h_ = 0; h_ < 2; ++h_) _Pragma("unroll") for (int i_ = 0; i_ < 2; ++i_) dst[h_][i_] = (unsigned)rt_[h_ * 128 + rowA[i_]] + voffA[i_]; } } while (0)
#define PG8_STAGE_A(bufoff, abase, h, NEXT) do { if constexpr (GATHER) { const unsigned vo_[2] = {(NEXT) ? vn[h][0] : va[h][0], (NEXT) ? vn[h][1] : va[h][1]}; PG8_STAGE(bufoff, abase, vo_); } \
        else { PG8_STAGE(bufoff, (abase) + (h) * hstep, voffA); } } while (0)
    const size_t kstep = (size_t)(BK * 2);
    const size_t hstep = (size_t)HALF * K * 2;
    const unsigned ldsw = (unsigned)wid * 1024u;
    const int aoff = F8 ? lds_byte_f8(wr * 64 + fr, 2 * fq) : lds_byte(wr * 64 + fr, fq * 8), boff = F8 ? lds_byte_f8(wc * 32 + fr, 2 * fq) : lds_byte(wc * 32 + fr, fq * 8);
    const int aoffx = F8 ? (aoff ^ 16) : aoff + 1024, boffx = F8 ? (boff ^ 16) : boff + 1024;
#define PG8_SA(b, h) (((b) * 2 + (h)) * HTB)
#define PG8_SB(b, h) ((4 + (b) * 2 + (h)) * HTB)
#define PG8_STAGE(bufoff, gbase, voff) do { _Pragma("unroll") for (int _i = 0; _i < 2; ++_i) \
        __builtin_amdgcn_global_load_lds((const unsigned*)((const char*)(gbase) + (voff)[_i]), (LAS unsigned*)(lds + (bufoff) + ldsw + _i * 8192), 16, 0, 0); } while (0)
#define PG8_LDA(dst, b, h) do { _Pragma("unroll") for (int m = 0; m < 4; ++m) _Pragma("unroll") for (int k = 0; k < 2; ++k) dst[m][k] = *(const LAS bf16x8*)(lds + PG8_SA(b, h) + (k ? aoffx : aoff) + m * 2048); } while (0)
#define PG8_LDB(dst, b, h) do { _Pragma("unroll") for (int n = 0; n < 2; ++n) _Pragma("unroll") for (int k = 0; k < 2; ++k) dst[n][k] = *(const LAS bf16x8*)(lds + PG8_SB(b, h) + (k ? boffx : boff) + n * 2048); } while (0)
#define PG8_J8(X) __builtin_bit_cast(v8i32, __builtin_shufflevector((X)[0], (X)[1], 0, 1, 2, 3, 4, 5, 6, 7, 8, 9, 10, 11, 12, 13, 14, 15))
#define PG8_MMA(ai, bj, At, Bt) do { __builtin_amdgcn_s_setprio(1); _Pragma("unroll") for (int m = 0; m < 4; ++m) _Pragma("unroll") for (int n = 0; n < 2; ++n) { \
        if constexpr (F8) { asm volatile("v_mfma_scale_f32_16x16x128_f8f6f4 %0, %1, %2, %0, %3, %3 op_sel_hi:[0,0,0]" : "+v"(acc[ai][bj][m][n]) : "v"(PG8_J8(Bt[n])), "v"(PG8_J8(At[m])), "v"(0x7f7f7f7f)); } \
        else { _Pragma("unroll") for (int k = 0; k < 2; ++k) acc[ai][bj][m][n] = __builtin_amdgcn_mfma_f32_16x16x32_bf16(Bt[n][k], At[m][k], acc[ai][bj][m][n], 0, 0, 0); } } \
        __builtin_amdgcn_s_setprio(0); } while (0)
#define PG8_WAIT_V(n) asm volatile("s_waitcnt vmcnt(" #n ")" ::: "memory")
#define PG8_WAIT_L(n) asm volatile("s_waitcnt lgkmcnt(" #n ")" ::: "memory")
#define PG8_BAR __builtin_amdgcn_s_barrier()
#define PG8_SCHED __builtin_amdgcn_sched_barrier(0)
    Unit cur, nxt; int ui = 0;
    if (!S.next(0, cur)) return;
    f32x4 acc[2][2][4][2];
#pragma unroll
    for (int a = 0; a < 2; ++a)
#pragma unroll
        for (int b = 0; b < 2; ++b)
#pragma unroll
            for (int m = 0; m < 4; ++m)
#pragma unroll
                for (int n = 0; n < 2; ++n) acc[a][b][m][n] = (f32x4){0.f, 0.f, 0.f, 0.f};
    bf16x8 At[4][2], B0[2][2], B1[2][2];
    typename Epi::Pre pre;
    const char* cA = S.aptr(cur); const char* cB = S.bptr(cur);
    PG8_ROWS(va, 0);
    PG8_STAGE(PG8_SB(0, 0), cB, voffB); PG8_STAGE(PG8_SB(0, 1), cB + hstep, voffB); PG8_STAGE_A(PG8_SA(0, 0), cA, 0, false); PG8_STAGE_A(PG8_SA(0, 1), cA, 1, false);
    if (wr == 1) PG8_BAR;
    PG8_WAIT_V(2); PG8_BAR;
    PG8_STAGE(PG8_SB(1, 0), cB + kstep, voffB); PG8_STAGE_A(PG8_SA(1, 0), cA + kstep, 0, false); PG8_STAGE(PG8_SB(1, 1), cB + hstep + kstep, voffB);
    PG8_WAIT_V(6); PG8_BAR;
    for (;;) {
        const bool has_next = S.next(ui + 1, nxt);
        const char* nA = has_next ? S.aptr(nxt) : cA; const char* nB = has_next ? S.bptr(nxt) : cB;
        const bool do0 = cur.half != 2, do1 = cur.half != 1;
        if constexpr (GATHER) { if (has_next) PG8_ROWS(vn, ui + 1); else { _Pragma("unroll") for (int h_ = 0; h_ < 2; ++h_) _Pragma("unroll") for (int i_ = 0; i_ < 2; ++i_) vn[h_][i_] = va[h_][i_]; } }
#pragma clang loop unroll(disable)
        for (int t = 0; t < nt; t += 2) {
            const bool last = (t == nt - 2);
            if constexpr (Epi::EARLY == 1) { if (last) E.prefetch(cur, wr, wc, pre); } else if constexpr (Epi::EARLY == 2) { if (last) E.prefetch_dma(cur, wc, lds + 8 * HTB + wid * 256); }
            const char* a1 = cA + (size_t)(t + 1) * kstep;
            const char* a2 = last ? nA : cA + (size_t)(t + 2) * kstep; const char* b2 = last ? nB : cB + (size_t)(t + 2) * kstep;
            const char* a3 = a2 + kstep; const char* b3 = b2 + kstep;
            PG8_LDB(B0, 0, 0); PG8_LDB(B1, 0, 1); PG8_SCHED; if (do0) PG8_LDA(At, 0, 0); PG8_STAGE_A(PG8_SA(1, 1), a1, 1, false);
            PG8_WAIT_V(8); PG8_WAIT_L(0); PG8_BAR; if (do0) { PG8_MMA(0, 0, At, B0); PG8_MMA(0, 1, At, B1); } PG8_BAR; PG8_SCHED;
            if (do1) PG8_LDA(At, 0, 1); PG8_STAGE(PG8_SB(0, 0), b2, voffB); PG8_STAGE(PG8_SB(0, 1), b2 + hstep, voffB); PG8_STAGE_A(PG8_SA(0, 0), a2, 0, last);
            PG8_WAIT_V(8); PG8_WAIT_L(0); PG8_BAR; if (do1) { PG8_MMA(1, 0, At, B0); PG8_MMA(1, 1, At, B1); } PG8_BAR; PG8_SCHED;
            PG8_LDB(B0, 1, 0); PG8_LDB(B1, 1, 1); PG8_SCHED; if (do0) PG8_LDA(At, 1, 0); PG8_STAGE_A(PG8_SA(0, 1), a2, 1, last);
            PG8_WAIT_V(8); PG8_WAIT_L(0); PG8_BAR; if (do0) { PG8_MMA(0, 0, At, B0); PG8_MMA(0, 1, At, B1); } PG8_BAR; PG8_SCHED;
            if (do1) PG8_LDA(At, 1, 1); PG8_STAGE(PG8_SB(1, 0), b3, voffB); PG8_STAGE(PG8_SB(1, 1), b3 + hstep, voffB); PG8_STAGE_A(PG8_SA(1, 0), a3, 0, last);
            PG8_WAIT_V(8); PG8_WAIT_L(0); PG8_BAR; if (do1) { PG8_MMA(1, 0, At, B0); PG8_MMA(1, 1, At, B1); } PG8_BAR; PG8_SCHED;
        }
        if (wr == 0) PG8_BAR;
        if constexpr (F8) asm volatile("s_nop 15\n\ts_nop 15" ::: "memory");
        if constexpr (Epi::EARLY == 0) E.prefetch(cur, wr, wc, pre); else if constexpr (Epi::EARLY == 2) E.load_pre(lds + 8 * HTB + wid * 256, pre);
        E(acc, cur, wr, wc, fr, fq, pre);
        if (!has_next) break;
#pragma unroll
        for (int a = 0; a < 2; ++a)
#pragma unroll
            for (int b = 0; b < 2; ++b)
#pragma unroll
                for (int m = 0; m < 4; ++m)
#pragma unroll
                    for (int n = 0; n < 2; ++n) acc[a][b][m][n] = (f32x4){0.f, 0.f, 0.f, 0.f};
        cur = nxt; cA = nA; cB = nB; ++ui;
        if constexpr (GATHER) { _Pragma("unroll") for (int h_ = 0; h_ < 2; ++h_) _Pragma("unroll") for (int i_ = 0; i_ < 2; ++i_) va[h_][i_] = vn[h_][i_]; }
        if (wr == 1) PG8_BAR;
    }
    PG8_WAIT_V(0);
    PG8_BAR;
#undef PG8_SA
#undef PG8_SB
#undef PG8_STAGE
#undef PG8_STAGE_A
#undef PG8_ROWS
#undef PG8_LDA
#undef PG8_LDB
#undef PG8_MMA
#undef PG8_J8
#undef PG8_WAIT_V
#undef PG8_WAIT_L
#undef PG8_BAR
#undef PG8_SCHED
}
}
using pg8::Unit;

struct SchedDense {
    const char* A; const char* B; int nM, nN, G, c; size_t tstep; bool split = false;
    DI bool next(int i, Unit& u) const { return pg8::order_next(i, G, c, nM, nN, u, 8, split); }
    DI const char* aptr(const Unit& u) const { return A + (size_t)u.pm * tstep; }
    DI const char* bptr(const Unit& u) const { return B + (size_t)u.pn * tstep; }
    DI const LAS int* rowtab(int) const { return nullptr; }
};
struct SchedUp {
    const char *A, *B; int G, c;
    DI bool next(int i, Unit& u) const { return pg8::order_next(i, G, c, NTOK / 256, 7, u); }
    DI const char* aptr(const Unit& u) const { return A + (size_t)(u.pn >= 3 ? 1 : 0) * (WS_CKVN - WS_CQN) + (size_t)u.pm * (256 * 256); }
    DI const char* bptr(const Unit& u) const { return B + (size_t)u.pn * (256 * 256); }
    DI const LAS int* rowtab(int) const { return nullptr; }
};
#ifndef MOE_WGM
#define MOE_WGM 4
#endif
struct SchedMoe {
    const char* A; const char* B; const LAS int* tile_e; int nM, nN, G, c; bool split = false;
    DI bool next(int i, Unit& u) const { return G == 256 ? pg8::order_moe(i, c, nM, nN, u, MOE_WGM, split) : pg8::order_next(i, G, c, nM, nN, u, MOE_WGM, split); }
    DI const char* aptr(const Unit& u) const { return A + (size_t)u.pm * (256 * 1024); }
    DI const char* bptr(const Unit& u) const { return B + ((size_t)__builtin_amdgcn_readfirstlane(tile_e[u.pm]) * nN + u.pn) * (256 * 1024); }
    DI const LAS int* rowtab(int) const { return nullptr; }
};
struct SchedMoeG {
    const char* A; const char* B; const LAS int* tile_e; const LAS int* rowtab_; int nM, nN, G, c; bool split = false;
    DI bool next(int i, Unit& u) const { return G == 256 ? pg8::order_moe(i, c, nM, nN, u, MOE_WGM, split) : pg8::order_next(i, G, c, nM, nN, u, MOE_WGM, split); }
    DI const char* aptr(const Unit&) const { return A; }
    DI const char* bptr(const Unit& u) const { return B + ((size_t)__builtin_amdgcn_readfirstlane(tile_e[u.pm]) * nN + u.pn) * (256 * 1024); }
    DI const LAS int* rowtab(int ui) const { return rowtab_ + ui * 256; }
};

#define EPI_LANE0() int z0_ = 0; asm volatile("" : "+v"(z0_)); const int ln0_ = (int)__builtin_amdgcn_mbcnt_hi(~0u, __builtin_amdgcn_mbcnt_lo(~0u, (unsigned)z0_)); const int fq = ln0_ >> 4
#define EPI_LANE() int z_ = 0; asm volatile("" : "+v"(z_)); const int ln_ = (int)__builtin_amdgcn_mbcnt_hi(~0u, __builtin_amdgcn_mbcnt_lo(~0u, (unsigned)z_)); const int fr = ln_ & 15, fq = ln_ >> 4; (void)fr_; (void)fq_
struct PreNone { };
struct Pre4 { f32x4 v[2][2]; };
struct EpiProj {
    static constexpr int EARLY = 0; static constexpr bool PERM = true; bf16_t* O; int ldc; float sc; typedef PreNone Pre;
    DI void prefetch(const Unit&, int, int, Pre&) const {}
    DI void operator()(const f32x4 (&acc)[2][2][4][2], const Unit& u, int wr, int wc, int fr_, int fq_, const Pre&) const {
        EPI_LANE();
        const int row0 = u.pm * 256 + wr * 64 + fr, col0 = u.pn * 256 + wc * 32 + 8 * fq;
#pragma unroll
        for (int ai = 0; ai < 2; ++ai)
#pragma unroll
            for (int m = 0; m < 4; ++m) { if (u.half != 0 && ai != u.half - 1) continue;     bf16_t* rowp = O + (size_t)(row0 + ai * 128 + m * 16) * ldc + col0;
#pragma unroll
                for (int bj = 0; bj < 2; ++bj) { const f32x4 v0 = acc[ai][bj][m][0] * sc, v1 = acc[ai][bj][m][1] * sc;
                    u32x4 w; w.x = cvtpk(v0[0], v0[1]); w.y = cvtpk(v0[2], v0[3]); w.z = cvtpk(v1[0], v1[1]); w.w = cvtpk(v1[2], v1[3]);
                    *(u32x4*)(rowp + bj * 128) = w; } }
    }
};
template <bool SRC_F32>
struct EpiOut {
    static constexpr int EARLY = 0; static constexpr bool PERM = false; bf16_t* XR; const float* xsrc; const float* gm; float sc; typedef Pre4 Pre;
    DI void prefetch(const Unit& u, int wr, int wc, Pre& pre) const { EPI_LANE0(); const int col0 = u.pn * 256 + wc * 32 + 4 * fq; const int b = u.pm >> 3;
#pragma unroll
        for (int bj = 0; bj < 2; ++bj)
#pragma unroll
            for (int n = 0; n < 2; ++n) pre.v[bj][n] = *(const f32x4*)(gm + b * 6144 + col0 + bj * 128 + n * 16) * sc; }
    DI void operator()(const f32x4 (&acc)[2][2][4][2], const Unit& u, int wr, int wc, int fr_, int fq_, const Pre& pre) const {
        EPI_LANE();
        const int row0 = u.pm * 256 + wr * 64 + fr, col0 = u.pn * 256 + wc * 32 + 4 * fq;
        const f32x4 (&g)[2][2] = pre.v;
#pragma unroll
        for (int ai = 0; ai < 2; ++ai)
#pragma unroll
            for (int m = 0; m < 4; ++m) { const size_t ro = (size_t)(row0 + ai * 128 + m * 16) * DM + col0;
#pragma unroll
                for (int bj = 0; bj < 2; ++bj)
#pragma unroll
                    for (int n = 0; n < 2; ++n) { const size_t o = ro + bj * 128 + n * 16; f32x4 r;
                        if constexpr (SRC_F32) r = *(const f32x4*)(xsrc + o); else { const u32x2 w = *(const u32x2*)(XR + o); r = (f32x4){bflo(w.x), bfhi(w.x), bflo(w.y), bfhi(w.y)}; }
                        r = r + g[bj][n] * acc[ai][bj][m][n];
                        u32x2 ow; ow.x = cvtpk(r[0], r[1]); ow.y = cvtpk(r[2], r[3]); *(u32x2*)(XR + o) = ow; } }
    }
};
struct EpiSwiglu {
    static constexpr int EARLY = 2; static constexpr bool PERM = true; unsigned char* O; const float* b1; const LAS int* tile_e; typedef Pre4 Pre;
    DI void prefetch(const Unit& u, int wr, int wc, Pre& pre) const { EPI_LANE0(); const int e = __builtin_amdgcn_readfirstlane(tile_e[u.pm]); const float* bb = b1 + e * 2048 + u.pn * 128 + wc * 32 + 8 * fq;
        pre.v[0][0] = *(const f32x4*)(bb); pre.v[0][1] = *(const f32x4*)(bb + 4); pre.v[1][0] = *(const f32x4*)(bb + 1024); pre.v[1][1] = *(const f32x4*)(bb + 1028); }
    DI void prefetch_dma(const Unit& u, int wc, LAS unsigned char* slot) const { int z0_ = 0; asm volatile("" : "+v"(z0_)); const int ln0_ = (int)__builtin_amdgcn_mbcnt_hi(~0u, __builtin_amdgcn_mbcnt_lo(~0u, (unsigned)z0_));
        const int e = __builtin_amdgcn_readfirstlane(tile_e[u.pm]); const float* src = b1 + e * 2048 + u.pn * 128 + wc * 32 + (ln0_ & 31) + (ln0_ >> 5) * 1024;
        __builtin_amdgcn_global_load_lds((const unsigned*)src, (LAS unsigned*)slot, 4, 0, 0); }
    DI void load_pre(const LAS unsigned char* slot, Pre& pre) const { EPI_LANE0(); const LAS float* sl_ = (const LAS float*)slot + 8 * fq;
        pre.v[0][0] = *(const LAS f32x4*)(sl_); pre.v[0][1] = *(const LAS f32x4*)(sl_ + 4); pre.v[1][0] = *(const LAS f32x4*)(sl_ + 32); pre.v[1][1] = *(const LAS f32x4*)(sl_ + 36); }
    DI void operator()(const f32x4 (&acc)[2][2][4][2], const Unit& u, int wr, int wc, int fr_, int fq_, const Pre& pre) const {
        EPI_LANE();
        const int row0 = u.pm * 256 + wr * 64 + fr, col0 = u.pn * 128 + wc * 32 + 8 * fq;
        constexpr float sc = 1.0f / (X_SCALE * W_SCALE);
        const f32x4 bg0 = pre.v[0][0], bg1 = pre.v[0][1], bl0 = pre.v[1][0], bl1 = pre.v[1][1];
#pragma unroll
        for (int ai = 0; ai < 2; ++ai)
#pragma unroll
            for (int m = 0; m < 4; ++m) { if (u.half != 0 && ai != u.half - 1) continue;
                float r[8];
#pragma unroll
                for (int q = 0; q < 4; ++q) { const f32x4 ag = acc[ai][0][m][q >> 1], al = acc[ai][1][m][q >> 1]; const f32x4 bg = (q >> 1) ? bg1 : bg0, bl = (q >> 1) ? bl1 : bl0; const int o = 2 * (q & 1);
                    f32x2 g = (f32x2){ag[o], ag[o + 1]} * sc + (f32x2){bg[o], bg[o + 1]}; f32x2 l = (f32x2){al[o], al[o + 1]} * sc + (f32x2){bl[o], bl[o + 1]};
                    g.x = fminf(g.x, 7.0f); g.y = fminf(g.y, 7.0f); l.x = __builtin_amdgcn_fmed3f(l.x, -7.0f, 7.0f); l.y = __builtin_amdgcn_fmed3f(l.y, -7.0f, 7.0f);
                    f32x2 t = g * (-1.702f * LOG2E); t.x = __builtin_amdgcn_exp2f(t.x); t.y = __builtin_amdgcn_exp2f(t.y);
                    f32x2 d = t + 1.0f; d.x = __builtin_amdgcn_rcpf(d.x); d.y = __builtin_amdgcn_rcpf(d.y);
                    const f32x2 lh = l * H_SCALE + H_SCALE; const f32x2 y = (g * d) * lh;
                    r[2 * q] = y.x; r[2 * q + 1] = y.y; }
                u32x2 w; w.x = pk4_fp8_nc(r[0], r[1], r[2], r[3]); w.y = pk4_fp8_nc(r[4], r[5], r[6], r[7]);
                *(u32x2*)(O + (size_t)(row0 + ai * 128 + m * 16) * DEXP + col0) = w; }
    }
};
struct EpiDown {
    static constexpr int EARLY = 1; static constexpr bool PERM = true; unsigned char* O; const float* b2; const LAS int* tile_e; typedef Pre4 Pre;
    DI void prefetch(const Unit& u, int wr, int wc, Pre& pre) const { EPI_LANE0(); const int e = __builtin_amdgcn_readfirstlane(tile_e[u.pm]); const int col0 = u.pn * 256 + wc * 32 + 8 * fq;
#pragma unroll
        for (int bj = 0; bj < 2; ++bj)
#pragma unroll
            for (int n = 0; n < 2; ++n) pre.v[bj][n] = *(const f32x4*)(b2 + e * 1024 + col0 + bj * 128 + 4 * n); }
    DI void operator()(const f32x4 (&acc)[2][2][4][2], const Unit& u, int wr, int wc, int fr_, int fq_, const Pre& pre) const {
        EPI_LANE();
        const int row0 = u.pm * 256 + wr * 64 + fr, col0 = u.pn * 256 + wc * 32 + 8 * fq;
        const f32x4 (&bv)[2][2] = pre.v;
#pragma unroll
        for (int ai = 0; ai < 2; ++ai)
#pragma unroll
            for (int m = 0; m < 4; ++m) { if (u.half != 0 && ai != u.half - 1) continue;     unsigned char* rowp = O + (size_t)(row0 + ai * 128 + m * 16) * DM + col0;
#pragma unroll
                for (int bj = 0; bj < 2; ++bj) { constexpr float sc = YE_SCALE / (H_SCALE * W_SCALE); const f32x4 v0 = acc[ai][bj][m][0] * sc + bv[bj][0] * YE_SCALE, v1 = acc[ai][bj][m][1] * sc + bv[bj][1] * YE_SCALE;
                    u32x2 w; w.x = pk4_fp8(v0[0], v0[1], v0[2], v0[3]); w.y = pk4_fp8(v1[0], v1[1], v1[2], v1[3]);
                    *(u32x2*)(rowp + bj * 128) = w; } }
    }
};

template <class RM>
DI void transpose_item(const float* W, int K, int N, bf16_t* WT, int ldt, LAS float* scr, int kb, int nb, int lane, RM rm) {
    const int k0 = 64 * kb, n0 = 32 * nb; const int nn = n0 + (lane & 31); const bool ok = nn < N;
#pragma unroll 8
    for (int i = 0; i < 32; ++i) { const int kk = 2 * i + (lane >> 5); scr[kk * 33 + (lane & 31)] = ok ? W[(size_t)(k0 + kk) * N + nn] : 0.f; }
    LDS_WAIT(); asm volatile("" ::: "memory");
    const int c = lane & 7;
#pragma unroll
    for (int j = 0; j < 4; ++j) { const int nl = (lane >> 3) + 8 * j; const int n = n0 + nl; const LAS float* s = scr + (8 * c) * 33 + nl;
        u32x4 o; o.x = cvtpk(s[0 * 33], s[1 * 33]); o.y = cvtpk(s[2 * 33], s[3 * 33]); o.z = cvtpk(s[4 * 33], s[5 * 33]); o.w = cvtpk(s[6 * 33], s[7 * 33]);
        if (n < N) *(u32x4*)(WT + (size_t)rm(n) * ldt + k0 + 8 * c) = o; }
    LDS_WAIT(); asm volatile("" ::: "memory");
}
template <class RM>
DI void transpose_item_f8(const float* W, int K, int N, unsigned char* WT, int ldt, LAS float* scr, int kb, int nb, int lane, RM rm, float sc) {
    const int k0 = 64 * kb, n0 = 32 * nb; const int nl = lane & 31, kh = lane >> 5;
#pragma unroll 8
    for (int i = 0; i < 32; ++i) { const int kk = 2 * i + kh; scr[kk * 33 + nl] = W[(size_t)(k0 + kk) * N + n0 + nl]; }
    LDS_WAIT(); asm volatile("" ::: "memory");
    const LAS float* s = scr + (32 * kh) * 33 + nl; unsigned w[8];
#pragma unroll
    for (int i = 0; i < 8; ++i) w[i] = pk4_fp8(s[(4 * i) * 33] * sc, s[(4 * i + 1) * 33] * sc, s[(4 * i + 2) * 33] * sc, s[(4 * i + 3) * 33] * sc);
    unsigned char* d = WT + (size_t)rm(n0 + nl) * ldt + k0 + 32 * kh;
    *(u32x4*)d = (u32x4){w[0], w[1], w[2], w[3]}; *(u32x4*)(d + 16) = (u32x4){w[4], w[5], w[6], w[7]};
    LDS_WAIT(); asm volatile("" ::: "memory");
}
struct RmId { DI int operator()(int n) const { return n; } };
struct RmIn { DI int operator()(int n) const { return n < 2112 ? n : (n < 2120 ? PC_WI + (n - 2112) : n - 8); } };
struct RmW1 { DI int operator()(int n) const { const int j = n & 1023; return 256 * (j >> 7) + (n >= 1024 ? 128 : 0) + (j & 127); } };

struct TDesc { const float* src; unsigned char* dst; int N, ldt, k0, n0, kind; };
DI void t_decode(KP p, unsigned char* ws, int it, TDesc& d) {
    constexpr int I_IN = 16 * 80, I_UQ = 4 * 24, I_UKV = 2 * 32, I_OUT = 16 * 32, I_W1 = 16 * 64, I_W2 = 16 * 32;
    constexpr int I_LAYER = I_IN + I_UQ + I_UKV + I_OUT + 32 * (I_W1 + I_W2);
    const int l = it / I_LAYER; int r = it % I_LAYER;
    if (r < I_IN) { d.src = p->w_in + (size_t)l * 1024 * D_IN; d.N = D_IN; d.k0 = 64 * (r / 80); d.n0 = 32 * (r % 80);
        if (d.n0 < PC_QI) { d.dst = ws + WS_WIN8 + (size_t)l * D_INP * 1024; d.ldt = 1024; d.kind = 2; } else { d.dst = ws + WS_WIN8 + (size_t)l * D_INP * 1024; d.ldt = 1024; d.kind = 4; }
        return; } r -= I_IN;
    if (r < I_UQ) { d.src = p->w_uq + (size_t)l * 256 * 768; d.N = 768; d.dst = ws + WS_WUP + (size_t)l * 1792 * 256; d.ldt = 256; d.k0 = 64 * (r / 24); d.n0 = 32 * (r % 24); d.kind = 2; return; } r -= I_UQ;
    if (r < I_UKV) { d.src = p->w_ukv + (size_t)l * 128 * 1024; d.N = 1024; d.dst = ws + WS_WUP + ((size_t)l * 1792 + 768) * 256; d.ldt = 256; d.k0 = 64 * (r / 32); d.n0 = 32 * (r % 32); d.kind = 2; return; } r -= I_UKV;
    if (r < I_OUT) { d.src = p->w_out + (size_t)l * 1024 * 1024; d.N = 1024; d.dst = ws + WS_WOUT + (size_t)l * 1024 * 1024; d.ldt = 1024; d.k0 = 64 * (r / 32); d.n0 = 32 * (r % 32); d.kind = 2; return; } r -= I_OUT;
    if (r < 32 * I_W1) { const int e = r / I_W1, q = r % I_W1; d.src = p->w1 + ((size_t)l * 32 + e) * 1024 * 2048; d.N = 2048; d.dst = ws + WS_W1 + ((size_t)l * 32 + e) * 2048 * 1024; d.ldt = 1024; d.k0 = 64 * (q / 64); d.n0 = 32 * (q % 64); d.kind = 3; return; } r -= 32 * I_W1;
    { const int e = r / I_W2, q = r % I_W2; d.src = p->w2 + ((size_t)l * 32 + e) * 1024 * 1024; d.N = 1024; d.dst = ws + WS_W2 + ((size_t)l * 32 + e) * 1024 * 1024; d.ldt = 1024; d.k0 = 64 * (q / 32); d.n0 = 32 * (q % 32); d.kind = 2; }
}
DI void t_load(const TDesc& d, int lane, f32x4 (&r)[8]) {
    const int kk = lane >> 3, nq = 4 * (lane & 7); const bool ok = d.n0 + nq < d.N;
    const float* s = d.src + (size_t)(d.k0 + kk) * d.N + d.n0 + nq;
#pragma unroll
    for (int i = 0; i < 8; ++i) r[i] = ok ? __builtin_nontemporal_load((const f32x4*)(s + (size_t)(8 * i) * d.N)) : (f32x4){0.f, 0.f, 0.f, 0.f};
}
DI void t_store(const TDesc& d, LAS float* scr, int lane, const f32x4 (&r)[8]) {
    { const int kk = lane >> 3, nq = 4 * (lane & 7);
#pragma unroll
      for (int i = 0; i < 8; ++i)
#pragma unroll
          for (int e = 0; e < 4; ++e) scr[(8 * i + kk) * 33 + nq + e] = r[i][e]; }
    LDS_WAIT(); asm volatile("" ::: "memory");
    if (d.kind < 2) {
        const int cc = lane & 7;
#pragma unroll
        for (int j = 0; j < 4; ++j) { const int nl = (lane >> 3) + 8 * j; const int n = d.n0 + nl; const LAS float* s = scr + (8 * cc) * 33 + nl;
            u32x4 o; o.x = cvtpk(s[0 * 33], s[1 * 33]); o.y = cvtpk(s[2 * 33], s[3 * 33]); o.z = cvtpk(s[4 * 33], s[5 * 33]); o.w = cvtpk(s[6 * 33], s[7 * 33]);
            const int row = d.kind == 1 ? (n < 2112 ? n : (n < 2120 ? PC_WI + (n - 2112) : n - 8)) : n;
            if (n < d.N) *(u32x4*)(d.dst + (size_t)row * d.ldt + (d.k0 + 8 * cc) * 2) = o; }
    } else {
        const int nl = lane & 31, kh = lane >> 5; const LAS float* s = scr + (32 * kh) * 33 + nl; unsigned w[8];
#pragma unroll
        for (int i = 0; i < 8; ++i) w[i] = pk4_fp8(s[(4 * i) * 33] * W_SCALE, s[(4 * i + 1) * 33] * W_SCALE, s[(4 * i + 2) * 33] * W_SCALE, s[(4 * i + 3) * 33] * W_SCALE);
        const int n = d.n0 + nl; const int jn = n & 1023;
        int row = n;
        if (d.kind == 3) row = 256 * (jn >> 7) + (n >= 1024 ? 128 : 0) + (jn & 127);
        else if (d.kind == 4) { row = n - 8; if (n < 2120) row = PC_WI + (n - 2112); if (n < 2112) row = n; if (n >= D_IN) row = 2552 + (n & 7); }
        unsigned char* o = d.dst + (size_t)row * d.ldt + d.k0 + 32 * kh;
        *(u32x4*)o = (u32x4){w[0], w[1], w[2], w[3]}; *(u32x4*)(o + 16) = (u32x4){w[4], w[5], w[6], w[7]};
    }
    LDS_WAIT(); asm volatile("" ::: "memory");
}
DI void big_src(KP p, int it, const float*& src, int& N, size_t& dstoff, int& k0, int& n0, int& w1map) {
    constexpr int I_W1 = 8 * 8, I_W2 = 8 * 4, I_L = 32 * (I_W1 + I_W2);
    const int l = it / I_L; int r = it % I_L;
    if (r < 32 * I_W1) { const int e = r / I_W1, q = r % I_W1; src = p->w1 + ((size_t)l * 32 + e) * 1024 * 2048; N = 2048; dstoff = WS_W1 + ((size_t)l * 32 + e) * 2048 * 1024; k0 = 128 * (q / 8); n0 = 256 * (q % 8); w1map = 1; }
    else { r -= 32 * I_W1; const int e = r / I_W2, q = r % I_W2; src = p->w2 + ((size_t)l * 32 + e) * 1024 * 1024; N = 1024; dstoff = WS_W2 + ((size_t)l * 32 + e) * 1024 * 1024; k0 = 128 * (q / 4); n0 = 256 * (q % 4); w1map = 0; }
}
DI void big_load(const float* src, int N, int k0, int n0, int wave, int lane, f32x4 (&r)[16]) {
    const float* s = src + (size_t)(k0 + 16 * wave) * N + n0 + 4 * lane;
#pragma unroll
    for (int i = 0; i < 16; ++i) r[i] = __builtin_nontemporal_load((const f32x4*)(s + (size_t)i * N));
}
constexpr int BIG_TOTAL = DEPTH * 32 * (8 * 8 + 8 * 4), BIG_L1 = 32 * (8 * 8 + 8 * 4), BIG_ND = 1024;
DI void big_convert(KP p, const Ctx& c, int first, int stride, int count, int limit, int thr, int add) {
    constexpr int TP = 260;
    LAS float* tile = (LAS float*)c.lds;
    const float* src; int N, k0, n0, w1m; size_t doff; f32x4 rc[16], rn[16];
    int r = first, j = 0;
    bool have = count > 0 && r < limit;
    if (have) { big_src(p, r + (r >= thr ? add : 0), src, N, doff, k0, n0, w1m); big_load(src, N, k0, n0, c.wave, c.lane, rc); }
    while (have) {
        const int rn_ = r + stride; ++j; const bool hn = j < count && rn_ < limit;
        const float* nsrc = src; int nN = N, nk0 = k0, nn0 = n0, nw1 = w1m; size_t ndoff = doff;
        if (hn) { big_src(p, rn_ + (rn_ >= thr ? add : 0), nsrc, nN, ndoff, nk0, nn0, nw1); big_load(nsrc, nN, nk0, nn0, c.wave, c.lane, rn); }
#pragma unroll
        for (int i = 0; i < 16; ++i) *(LAS f32x4*)(tile + (16 * c.wave + i) * TP + 4 * c.lane) = rc[i];
        __syncthreads();
        { const int nl = c.tid >> 1, kh = c.tid & 1;
          const LAS float* t0 = tile + (64 * kh) * TP + nl; unsigned w[16];
#pragma unroll
          for (int i = 0; i < 16; ++i) w[i] = pk4_fp8(t0[(4 * i) * TP] * W_SCALE, t0[(4 * i + 1) * TP] * W_SCALE, t0[(4 * i + 2) * TP] * W_SCALE, t0[(4 * i + 3) * TP] * W_SCALE);
          const int n = n0 + nl; const int jn = n & 1023; const int row = w1m ? 256 * (jn >> 7) + (n >= 1024 ? 128 : 0) + (jn & 127) : n;
          unsigned char* o = c.ws + doff + (size_t)row * 1024 + k0 + 64 * kh;
#pragma unroll
          for (int q = 0; q < 4; ++q) *(u32x4*)(o + 16 * q) = (u32x4){w[4 * q], w[4 * q + 1], w[4 * q + 2], w[4 * q + 3]}; }
        __syncthreads();
        if (!hn) break;
        src = nsrc; N = nN; k0 = nk0; n0 = nn0; w1m = nw1; doff = ndoff; r = rn_;
#pragma unroll
        for (int i = 0; i < 16; ++i) rc[i] = rn[i];
    }
}
DI void phase_prologue(KP p, const Ctx& c) {
    LAS float* scr = (LAS float*)(c.lds + c.wave * 16384);
    bf16_t* WUP = (bf16_t*)(c.ws + WS_WUP);
    {
        constexpr int I_SMALL = 16 * 80 + 4 * 24 + 2 * 32 + 16 * 32;
        constexpr int I_LAYER = I_SMALL + 32 * (16 * 64 + 16 * 32);
        for (int j = c.gw; j < DEPTH * I_SMALL; j += c.NGW) { const int it = (j / I_SMALL) * I_LAYER + (j % I_SMALL);
            TDesc dc; f32x4 rc[8]; t_decode(p, c.ws, it, dc); t_load(dc, c.lane, rc); t_store(dc, scr, c.lane, rc); }
    }
    __syncthreads();
    big_convert(p, c, c.vcu, c.G, 1 << 20, BIG_TOTAL - BIG_ND, BIG_L1, BIG_ND);
    __syncthreads();
    for (int i = c.gw * 64 + c.lane; i < DEPTH * 1024 * 8; i += c.NGW * 64) { const int l = i >> 13, row = (i >> 3) & 1023, ch = i & 7; *(u32x4*)((unsigned char*)WUP + ((size_t)l * 1792 + 768 + row) * 256 + 128 + ch * 16) = (u32x4){0u, 0u, 0u, 0u}; }
    {
        float* ROPE = (float*)(c.ws + WS_ROPE);
        for (int i = c.gw * 64 + c.lane; i < NTOK * 16; i += c.NGW * 64) { const int m = i >> 4, j = i & 15;
            const float inv = (float)pow(10000.0, -(double)j / 16.0);
            const float ang = (float)p->pos[m] * inv;
            const double a = (double)ang; const double n = rint(a * 0.15915494309189535); const double rr = a - n * 6.283185307179586476925;
            const float rf = (float)rr;
            ROPE[m * 32 + j] = cosf(rf); ROPE[m * 32 + 16 + j] = sinf(rf); }
    }
    __syncthreads();
    {
        LAS float* cond = (LAS float*)c.lds;
        LAS float* red = (LAS float*)(c.lds + 32768);
        float* MODS = (float*)(c.ws + WS_MODS);
        bool have = false;
        for (int it = c.vcu; it < DEPTH * 96; it += c.G) {
            if (!have) { for (int i = c.tid; i < 8192; i += 512) { const int b = i >> 10, k = i & 1023; const float v = p->c[b * 1024 + k]; cond[k * 8 + b] = v / (1.0f + __expf(-v)); } have = true; __syncthreads(); }
            const int l = it / 96, j0 = (it % 96) * 64;
            const float* W = p->w_ada + (size_t)l * 1024 * 6144 + j0 + c.lane;
            float a[8] = {0.f, 0.f, 0.f, 0.f, 0.f, 0.f, 0.f, 0.f};
#pragma unroll 32
            for (int kk = 0; kk < 128; ++kk) { const int k = c.wave * 128 + kk; const float w = W[(size_t)k * 6144];
                const f32x4 c0 = *(const LAS f32x4*)(cond + k * 8), c1 = *(const LAS f32x4*)(cond + k * 8 + 4);
                a[0] += c0[0] * w; a[1] += c0[1] * w; a[2] += c0[2] * w; a[3] += c0[3] * w; a[4] += c1[0] * w; a[5] += c1[1] * w; a[6] += c1[2] * w; a[7] += c1[3] * w; }
#pragma unroll
            for (int b = 0; b < 8; ++b) red[(c.wave * 8 + b) * 64 + c.lane] = a[b];
            __syncthreads();
            { const int b = c.tid >> 6, j = c.tid & 63; float s = p->b_ada[l * 6144 + j0 + j];
#pragma unroll
              for (int w = 0; w < 8; ++w) s += red[(w * 8 + b) * 64 + j];
              MODS[(l * 8 + b) * 6144 + j0 + j] = s; }
            __syncthreads();
        }
    }
}

DI int build_tiles(const Ctx& c, int layer) {
    const unsigned* gcnt = (const unsigned*)(c.ws + WS_CTL) + CW_GCNT + layer * 64;
    LAS int* pst = (LAS int*)(c.lds + LC_PST); LAS int* tile_e = (LAS int*)(c.lds + LC_TILEE);
    __syncthreads();
    LAS int* cnt = (LAS int*)(c.lds + LC_CNT);
    if (c.tid < 32) cnt[c.tid] = (int)__hip_atomic_load(&gcnt[c.tid], __ATOMIC_RELAXED, __HIP_MEMORY_SCOPE_AGENT);
    __syncthreads();
    if (c.tid < 64) {
        const int e = c.tid & 31; const int n = (cnt[e] + 255) >> 8; int incl = n;
#pragma unroll
        for (int o = 1; o < 32; o <<= 1) { const int v = __builtin_amdgcn_ds_bpermute(((c.tid - o) & 63) << 2, incl); if (e >= o) incl += v; }
        const int st = incl - n;
        if (c.tid < 32) { pst[e] = st; if (e == 31) pst[32] = incl; for (int i = 0; i < n; ++i) tile_e[st + i] = e; }
    }
    __syncthreads();
    return pst[32];
}
DI int reuse_tiles(const Ctx& c, int layer) {
#if MULTI_LAUNCH
    return build_tiles(c, layer);
#else
    (void)layer; __syncthreads(); return ((const LAS int*)(c.lds + LC_PST))[32];
#endif
}
DI void load_row(const float* src, int lane, f32x4 (&v)[4]) {
#pragma unroll
    for (int j = 0; j < 4; ++j) v[j] = *(const f32x4*)(src + 4 * lane + 256 * j);
}
DI void load_row_bf(const bf16_t* src, int lane, f32x4 (&v)[4]) {
#pragma unroll
    for (int j = 0; j < 4; ++j) { const u32x2 w = *(const u32x2*)(src + 4 * lane + 256 * j); v[j] = (f32x4){bflo(w.x), bfhi(w.x), bflo(w.y), bfhi(w.y)}; }
}
template <int RB>
DI void moe_combine(const Ctx& c, int m0, const float* MODS_gf  , f32x4 (&v)[RB][4]) {
    const int* ME = (const int*)(c.ws + WS_ME); const int* MR = (const int*)(c.ws + WS_MR); const float* MG = (const float*)(c.ws + WS_MG); const unsigned char* Y = c.ws + WS_YEXP;
    const LAS int* pst = (const LAS int*)(c.lds + LC_PST);
    int me[RB][4], mr[RB][4]; float mg[RB][4];
#pragma unroll
    for (int i = 0; i < RB; ++i)
#pragma unroll
        for (int k = 0; k < 4; ++k) { me[i][k] = ME[(m0 + i) * 4 + k]; mr[i][k] = MR[(m0 + i) * 4 + k]; mg[i][k] = MG[(m0 + i) * 4 + k]; }
    unsigned w[RB][4][4];
#pragma unroll
    for (int i = 0; i < RB; ++i)
#pragma unroll
        for (int k = 0; k < 4; ++k) { const int d = pst[me[i][k]] * 256 + mr[i][k]; const unsigned char* row = Y + (size_t)d * DM + 4 * c.lane;
#pragma unroll
            for (int j = 0; j < 4; ++j) w[i][k][j] = *(const unsigned*)(row + 256 * j); }
#pragma unroll
    for (int i = 0; i < RB; ++i) { const int b = (m0 + i) >> 11; f32x4 a[4];
#pragma unroll
        for (int j = 0; j < 4; ++j) a[j] = (f32x4){0.f, 0.f, 0.f, 0.f};
#pragma unroll
        for (int k = 0; k < 4; ++k) { const float g = mg[i][k] * (1.0f / YE_SCALE);
#pragma unroll
            for (int j = 0; j < 4; ++j) { const int ww = (int)w[i][k][j]; const f32x2 lo = __builtin_amdgcn_cvt_pk_f32_fp8(ww, false), hi2 = __builtin_amdgcn_cvt_pk_f32_fp8(ww, true);
                a[j][0] += g * lo[0]; a[j][1] += g * lo[1]; a[j][2] += g * hi2[0]; a[j][3] += g * hi2[1]; } }
#pragma unroll
        for (int j = 0; j < 4; ++j) { const f32x4 g = *(const f32x4*)(MODS_gf + b * 6144 + 4 * c.lane + 256 * j); v[i][j] = v[i][j] + g * a[j]; } }
}
DI float row_rinv(const f32x4 (&v)[4], int lane) {
    float s = 0.f;
#pragma unroll
    for (int j = 0; j < 4; ++j) s += (v[j][0] * v[j][0] + v[j][1] * v[j][1]) + (v[j][2] * v[j][2] + v[j][3] * v[j][3]);
    s = wave_sum(s, lane);
    return 1.0f / sqrtf(s * (1.0f / 1024.0f) + EPS);
}
DI void modulate(const f32x4 (&v)[4], float r, const float* nw, const float* sh, const float* sc, int lane, f32x4 (&h)[4]) {
#pragma unroll
    for (int j = 0; j < 4; ++j) { const int o = 4 * lane + 256 * j; const f32x4 w = *(const f32x4*)(nw + o), a = *(const f32x4*)(sc + o), s = *(const f32x4*)(sh + o);
        h[j] = v[j] * r * w * (a + 1.0f) + s; }
}
DI void store_row_bf16(bf16_t* dst, int lane, const f32x4 (&h)[4]) {
#pragma unroll
    for (int j = 0; j < 4; ++j) { u32x2 w; w.x = cvtpk(h[j][0], h[j][1]); w.y = cvtpk(h[j][2], h[j][3]); *(u32x2*)(dst + 4 * lane + 256 * j) = w; }
}

DI void phase_norm_mix(KP p, const Ctx& c, int layer) {
    bf16_t* XR = (bf16_t*)(c.ws + WS_XR); const float* MODS = (const float*)(c.ws + WS_MODS);
    if (layer > 0) (void)reuse_tiles(c, layer - 1);
    constexpr int RB = 2;
    for (int mm = c.lw * RB; mm < c.rcnt; mm += c.NLW * RB) { const int m0 = c.rbase + mm;
        f32x4 v[RB][4];
#pragma unroll
        for (int i = 0; i < RB; ++i) { if (layer == 0) load_row(p->x + (size_t)(m0 + i) * DM, c.lane, v[i]); else load_row_bf(XR + (size_t)(m0 + i) * DM, c.lane, v[i]); }
        if (layer > 0) moe_combine<RB>(c, m0, MODS + (layer > 0 ? layer - 1 : 0) * 8 * 6144 + 5 * 1024, v);
#pragma unroll
        for (int i = 0; i < RB; ++i) { const int m = m0 + i, b = m >> 11; f32x4 h[4];
            if (layer > 0) store_row_bf16(XR + (size_t)m * DM, c.lane, v[i]);
            const float r = row_rinv(v[i], c.lane);
            const float* md = MODS + (layer * 8 + b) * 6144;
            modulate(v[i], r, p->norm_mix + layer * 1024, md, md + 1024, c.lane, h);
#pragma unroll
            for (int j = 0; j < 4; ++j) *(unsigned*)(c.ws + WS_H8IN + (size_t)m * DM + 4 * c.lane + 256 * j) = pk4_fp8(h[j][0] * X_SCALE, h[j][1] * X_SCALE, h[j][2] * X_SCALE, h[j][3] * X_SCALE); }
    }
}
DI void phase_final(KP p, const Ctx& c) {
    const bf16_t* XR = (const bf16_t*)(c.ws + WS_XR); const float* MODS = (const float*)(c.ws + WS_MODS);
    (void)reuse_tiles(c, DEPTH - 1);
    constexpr int RB = 2;
    for (int m0 = c.gw * RB; m0 < NTOK; m0 += c.NGW * RB) {
        f32x4 v[RB][4];
#pragma unroll
        for (int i = 0; i < RB; ++i) load_row_bf(XR + (size_t)(m0 + i) * DM, c.lane, v[i]);
        moe_combine<RB>(c, m0, MODS + (DEPTH - 1) * 8 * 6144 + 5 * 1024, v);
#pragma unroll
        for (int i = 0; i < RB; ++i) { const int m = m0 + i; const float r = row_rinv(v[i], c.lane);
#pragma unroll
            for (int j = 0; j < 4; ++j) { const int o = 4 * c.lane + 256 * j; const f32x4 w = *(const f32x4*)(p->norm_final + o); *(f32x4*)(p->out + (size_t)m * DM + o) = v[i][j] * r * w; } }
    }
}

DI void prep_rows(KP p, const Ctx& c, int layer) {
    const bf16_t* PROJ = (const bf16_t*)(c.ws + WS_PROJ); bf16_t* CQN = (bf16_t*)(c.ws + WS_CQN); bf16_t* CKVN = (bf16_t*)(c.ws + WS_CKVN); bf16_t* KR = (bf16_t*)(c.ws + WS_KR);
    const float* ROPE = (const float*)(c.ws + WS_ROPE);
    const f32x4 gq = *(const f32x4*)(p->q_norm + layer * 256 + 4 * c.lane); const f32x2 gk = *(const f32x2*)(p->kv_norm + layer * 128 + 2 * c.lane);
    constexpr int RB = 4;
    for (int mm = c.lw * RB; mm < c.rcnt; mm += c.NLW * RB) { const int m0 = c.rbase + mm;
        u32x2 wq[RB]; unsigned wk[RB]; float r1[RB], r2[RB], rc[RB], rs[RB];
        const int l16 = c.lane & 15;
#pragma unroll
        for (int i = 0; i < RB; ++i) { const bf16_t* pr = PROJ + (size_t)(m0 + i) * D_INP;
            wq[i] = *(const u32x2*)(pr + PC_CQ + 4 * c.lane); wk[i] = *(const unsigned*)(pr + PC_CKV + 2 * c.lane);
            r1[i] = bf1(pr[PC_KR + l16]); r2[i] = bf1(pr[PC_KR + 16 + l16]); rc[i] = ROPE[(m0 + i) * 32 + l16]; rs[i] = ROPE[(m0 + i) * 32 + 16 + l16]; }
#pragma unroll
        for (int i = 0; i < RB; ++i) { const int m = m0 + i;
            { const float x0 = bflo(wq[i].x), x1 = bfhi(wq[i].x), x2 = bflo(wq[i].y), x3 = bfhi(wq[i].y);
              const float s = wave_sum(x0 * x0 + x1 * x1 + x2 * x2 + x3 * x3, c.lane); const float r = 1.0f / sqrtf(s * (1.0f / 256.0f) + EPS);
              const float rs_ = r * X_SCALE; *(unsigned*)((unsigned char*)CQN + (size_t)m * 256 + 4 * c.lane) = pk4_fp8(x0 * rs_ * gq[0], x1 * rs_ * gq[1], x2 * rs_ * gq[2], x3 * rs_ * gq[3]); }
            { const float x0 = bflo(wk[i]), x1 = bfhi(wk[i]);
              const float s = wave_sum(x0 * x0 + x1 * x1, c.lane); const float r = 1.0f / sqrtf(s * (1.0f / 128.0f) + EPS);
              const float rs_ = r * X_SCALE; *(unsigned short*)((unsigned char*)CKVN + (size_t)m * 256 + 2 * c.lane) = (unsigned short)(pk4_fp8(x0 * rs_ * gk[0], x1 * rs_ * gk[1], 0.f, 0.f) & 0xffffu);
              *(unsigned short*)((unsigned char*)CKVN + (size_t)m * 256 + 128 + 2 * c.lane) = (unsigned short)0; }
            if (c.lane < 16) { KR[(size_t)m * 32 + c.lane] = (bf16_t)(cvtpk(r1[i] * rc[i] - r2[i] * rs[i], 0.f) & 0xffffu); KR[(size_t)m * 32 + 16 + c.lane] = (bf16_t)(cvtpk(r2[i] * rc[i] + r1[i] * rs[i], 0.f) & 0xffffu); }
        }
    }
}
constexpr int SC_LD = 2052;
DI unsigned okey(float f) { const unsigned u = __float_as_uint(f); return (u & 0x80000000u) ? ~u : (u | 0x80000000u); }
DI void idx_load(const Ctx& c, int b, int g, bf16x8 (&qf)[8][2], u32x4& wraw, bf16x8 (&ka)[8][2]) {
    const bf16_t* PROJ = (const bf16_t*)(c.ws + WS_PROJ);
    const int qbase = 16 * g, nkb = 4 * ((g >> 2) + 1); const int l15 = c.lane & 15, l4 = c.lane >> 4;
    const bf16_t* qrow = PROJ + (size_t)(b * SEQ + qbase + l15) * D_INP;
#pragma unroll
    for (int h = 0; h < 8; ++h)
#pragma unroll
        for (int ks = 0; ks < 2; ++ks) qf[h][ks] = *(const bf16x8*)(qrow + PC_QI + 64 * h + 32 * ks + 8 * l4);
    wraw = *(const u32x4*)(qrow + PC_WI);
    const bf16_t* kbase = PROJ + (size_t)(b * SEQ + l15) * D_INP + PC_KI + 8 * l4; const size_t kstride = (size_t)16 * D_INP;
#pragma unroll
    for (int d = 0; d < 8; ++d) { const int kb = c.wave + 8 * d; const int kc = kb < nkb ? kb : 0; ka[d][0] = *(const bf16x8*)(kbase + kc * kstride); ka[d][1] = *(const bf16x8*)(kbase + kc * kstride + 32); }
}
DI void idx_scores(const Ctx& c, int b, int g, const bf16x8 (&qf)[8][2], const u32x4& w, bf16x8 (&ka)[8][2]) {
    const bf16_t* PROJ = (const bf16_t*)(c.ws + WS_PROJ); LAS float* sc = (LAS float*)c.lds;
    const int nkb = 4 * ((g >> 2) + 1); const int l15 = c.lane & 15, l4 = c.lane >> 4;
    const float wh[8] = {bflo(w.x), bfhi(w.x), bflo(w.y), bfhi(w.y), bflo(w.z), bfhi(w.z), bflo(w.w), bfhi(w.w)};
    const bf16_t* kbase = PROJ + (size_t)(b * SEQ + l15) * D_INP + PC_KI + 8 * l4; const size_t kstride = (size_t)16 * D_INP;
    const int nmine = (nkb - c.wave + 7) >> 3;
#pragma unroll 1
    for (int i0 = 0; i0 < nmine; i0 += 8) {
        if (i0 > 0) {
#pragma unroll
            for (int d = 0; d < 8; ++d) { const int kb = c.wave + 8 * (i0 + d); const int kc = kb < nkb ? kb : 0; ka[d][0] = *(const bf16x8*)(kbase + kc * kstride); ka[d][1] = *(const bf16x8*)(kbase + kc * kstride + 32); } }
#pragma unroll
        for (int d = 0; d < 8; ++d) { const int i = i0 + d; if (i < nmine) {
            const int kb = c.wave + 8 * i;
            f32x4 s = {0.f, 0.f, 0.f, 0.f};
#pragma unroll
            for (int h = 0; h < 8; ++h) { f32x4 a = {0.f, 0.f, 0.f, 0.f};
                a = __builtin_amdgcn_mfma_f32_16x16x32_bf16(ka[d][0], qf[h][0], a, 0, 0, 0);
                a = __builtin_amdgcn_mfma_f32_16x16x32_bf16(ka[d][1], qf[h][1], a, 0, 0, 0);
#pragma unroll
                for (int e = 0; e < 4; ++e) s[e] += wh[h] * fmaxf(a[e], 0.f); }
            *(LAS f32x4*)(sc + l15 * SC_LD + 16 * kb + 4 * l4) = s; } }
    }
}
#define SEL_CMP8(OP) asm(OP " %0, %8, %16\n\t" OP " %1, %9, %16\n\t" OP " %2, %10, %16\n\t" OP " %3, %11, %16\n\t" OP " %4, %12, %16\n\t" OP " %5, %13, %16\n\t" OP " %6, %14, %16\n\t" OP " %7, %15, %16" \
        : "=&s"(m0), "=&s"(m1), "=&s"(m2), "=&s"(m3), "=&s"(m4), "=&s"(m5), "=&s"(m6), "=&s"(m7) \
        : "v"(u[g]), "v"(u[g + 1]), "v"(u[g + 2]), "v"(u[g + 3]), "v"(u[g + 4]), "v"(u[g + 5]), "v"(u[g + 6]), "v"(u[g + 7]), "v"(cand))
DI unsigned ikey(unsigned k) { return (k & 0x80000000u) ? (k & 0x7fffffffu) : ~k; }
DI int sel_count_ge(const unsigned (&u)[32], unsigned ckey, int nj) {
    int cnt = 0; const unsigned cand = ikey(ckey);
#pragma unroll
    for (int g = 0; g < 32; g += 8) if (g < nj) { unsigned long long m0, m1, m2, m3, m4, m5, m6, m7; SEL_CMP8("v_cmp_ge_f32_e64");
        cnt += (__builtin_popcountll(m0) + __builtin_popcountll(m1)) + (__builtin_popcountll(m2) + __builtin_popcountll(m3)) + (__builtin_popcountll(m4) + __builtin_popcountll(m5)) + (__builtin_popcountll(m6) + __builtin_popcountll(m7)); }
    return cnt;
}
DI int sel_count_gt(const unsigned (&u)[32], unsigned ckey) {
    int cnt = 0; const unsigned cand = ikey(ckey);
#pragma unroll
    for (int g = 0; g < 32; g += 8) { unsigned long long m0, m1, m2, m3, m4, m5, m6, m7; SEL_CMP8("v_cmp_gt_f32_e64");
        cnt += (__builtin_popcountll(m0) + __builtin_popcountll(m1)) + (__builtin_popcountll(m2) + __builtin_popcountll(m3)) + (__builtin_popcountll(m4) + __builtin_popcountll(m5)) + (__builtin_popcountll(m6) + __builtin_popcountll(m7)); }
    return cnt;
}
DI void idx_select(const Ctx& c, int b, int g) {
    unsigned long long* MASK = (unsigned long long*)(c.ws + WS_MASK); LAS float* sc = (LAS float*)c.lds;
    const int qbase = 16 * g, nvis = 64 * ((g >> 2) + 1);
    {
        const int nj = nvis >> 6;
        for (int qq = 0; qq < 2; ++qq) {
            const int q = 2 * c.wave + qq; const LAS float* row = sc + q * SC_LD;
            int wlo = 0, whi = 0;
            if (nvis <= 256) { wlo = whi = (c.lane < nj) ? -1 : 0; }
            else {
                unsigned u[32]; float fmx = -INFINITY;
#pragma unroll
                for (int j = 0; j < 32; ++j) { const float f = (j < nj) ? row[64 * j + c.lane] : -INFINITY; u[j] = __float_as_uint(f); fmx = fmaxf(fmx, f); }
                fmx = fmaxf(fmx, __int_as_float(__builtin_amdgcn_update_dpp(__float_as_int(fmx), __float_as_int(fmx), 0xB1, 0xF, 0xF, false)));
                fmx = fmaxf(fmx, __int_as_float(__builtin_amdgcn_update_dpp(__float_as_int(fmx), __float_as_int(fmx), 0x4E, 0xF, 0xF, false)));
                fmx = fmaxf(fmx, __int_as_float(__builtin_amdgcn_update_dpp(__float_as_int(fmx), __float_as_int(fmx), 0x141, 0xF, 0xF, false)));
                fmx = fmaxf(fmx, __int_as_float(__builtin_amdgcn_update_dpp(__float_as_int(fmx), __float_as_int(fmx), 0x140, 0xF, 0xF, false)));
                const float fm01 = fmaxf(__int_as_float(__builtin_amdgcn_readlane(__float_as_int(fmx), 0)), __int_as_float(__builtin_amdgcn_readlane(__float_as_int(fmx), 16)));
                const float fm23 = fmaxf(__int_as_float(__builtin_amdgcn_readlane(__float_as_int(fmx), 32)), __int_as_float(__builtin_amdgcn_readlane(__float_as_int(fmx), 48)));
                const unsigned umax = okey(fmaxf(fm01, fm23));
                unsigned T = umax & 0xff800000u; bool exact = false; bool found = false;
                for (int st = 0; st < 3; ++st) { const int cnt = sel_count_ge(u, T, nj);
                    if (cnt >= 256) { found = true; exact = cnt == 256; break; }
                    if (st < 2 && T >= (1u << 23)) T -= 1u << 23; }
                if (!found) { unsigned lo9 = 0u, hi9 = T >> 23;
                    while (hi9 - lo9 > 1u) { const unsigned mid = (lo9 + hi9) >> 1; const int cnt = sel_count_ge(u, mid << 23, nj);
                        if (cnt >= 256) { lo9 = mid; if (cnt == 256) { exact = true; break; } } else hi9 = mid; }
                    T = lo9 << 23; }
                if (!exact)
                for (int bit = 22; bit >= 0; --bit) {
                    const unsigned cand = T | (1u << bit);
                    const int cnt = sel_count_ge(u, cand, nj);
                    if (cnt >= 256) { T = cand; if (cnt == 256) { exact = true; break; } }
                }
                if (exact) {
                    const unsigned cand = ikey(T);
#pragma unroll
                    for (int g = 0; g < 32; g += 8) if (g < nj) { unsigned long long m0, m1, m2, m3, m4, m5, m6, m7; SEL_CMP8("v_cmp_ge_f32_e64");
                        asm("v_writelane_b32 %0, %2, %18\n\tv_writelane_b32 %1, %3, %18\n\tv_writelane_b32 %0, %4, %19\n\tv_writelane_b32 %1, %5, %19\n\tv_writelane_b32 %0, %6, %20\n\tv_writelane_b32 %1, %7, %20\n\tv_writelane_b32 %0, %8, %21\n\tv_writelane_b32 %1, %9, %21\n\t"
                            "v_writelane_b32 %0, %10, %22\n\tv_writelane_b32 %1, %11, %22\n\tv_writelane_b32 %0, %12, %23\n\tv_writelane_b32 %1, %13, %23\n\tv_writelane_b32 %0, %14, %24\n\tv_writelane_b32 %1, %15, %24\n\tv_writelane_b32 %0, %16, %25\n\tv_writelane_b32 %1, %17, %25"
                            : "+v"(wlo), "+v"(whi)
                            : "s"((int)(unsigned)m0), "s"((int)(unsigned)(m0 >> 32)), "s"((int)(unsigned)m1), "s"((int)(unsigned)(m1 >> 32)), "s"((int)(unsigned)m2), "s"((int)(unsigned)(m2 >> 32)), "s"((int)(unsigned)m3), "s"((int)(unsigned)(m3 >> 32)),
                              "s"((int)(unsigned)m4), "s"((int)(unsigned)(m4 >> 32)), "s"((int)(unsigned)m5), "s"((int)(unsigned)(m5 >> 32)), "s"((int)(unsigned)m6), "s"((int)(unsigned)(m6 >> 32)), "s"((int)(unsigned)m7), "s"((int)(unsigned)(m7 >> 32)),
                              "n"(g), "n"(g + 1), "n"(g + 2), "n"(g + 3), "n"(g + 4), "n"(g + 5), "n"(g + 6), "n"(g + 7)); }
                } else {
                    const int need = 256 - sel_count_gt(u, T); int eqbase = 0; const float Tf = __uint_as_float(ikey(T));
#pragma unroll
                    for (int j = 0; j < 32; ++j) { const float uf = __uint_as_float(u[j]); const unsigned long long eq = __ballot(uf == Tf);
                        const int rank = eqbase + (int)__builtin_amdgcn_mbcnt_hi((unsigned)(eq >> 32), __builtin_amdgcn_mbcnt_lo((unsigned)eq, 0u));
                        const unsigned long long sel = __ballot(uf > Tf || (uf == Tf && rank < need)); eqbase += __builtin_popcountll(eq);
                        asm("s_nop 3\n\tv_writelane_b32 %0, %2, %4\n\tv_writelane_b32 %1, %3, %4" : "+v"(wlo), "+v"(whi) : "s"((int)(unsigned)sel), "s"((int)(unsigned)(sel >> 32)), "n"(j)); }
                }
            }
            if (c.lane < 32) MASK[(size_t)(b * SEQ + qbase + q) * 32 + c.lane] = ((unsigned long long)(unsigned)whi << 32) | (unsigned)wlo;
        }
    }
}
DI void phase_prep_indexer(KP p, const Ctx& c, int layer) {
    prep_rows(p, c, layer);
    for (int v = c.vcu; v < 256; v += c.G) { const int b = v >> 5, s = v & 31;
        bf16x8 qf[8][2]; u32x4 wraw; bf16x8 ka[8][2];
        idx_load(c, b, 127 - s, qf, wraw, ka);
#pragma unroll
        for (int i = 0; i < 4; ++i) { const int g = i == 0 ? 127 - s : (i == 1 ? 64 + s : (i == 2 ? 63 - s : s)); const int gn = i == 0 ? 64 + s : (i == 1 ? 63 - s : s);
            idx_scores(c, b, g, qf, wraw, ka);
            __syncthreads();
            if (i < 3) idx_load(c, b, gn, qf, wraw, ka);
            idx_select(c, b, g);
            __syncthreads(); }
    }
}

template <bool MLA>
DI void attn_unit(const Ctx& c, const float* rel_bias, int b, int h, int qb) {
    constexpr int NKS = MLA ? 6 : 4;
    constexpr int SLOTB = MLA ? 20480 : 20480;
    constexpr int XOFF = 8192, VOFF = 12288, NSLOT = 4, LUTOFF = NSLOT * SLOTB;
    const bf16_t* PROJ = (const bf16_t*)(c.ws + WS_PROJ); const bf16_t* UPO = (const bf16_t*)(c.ws + WS_UPO);
    const bf16_t* KRB = (const bf16_t*)(c.ws + WS_KR); const float* ROPE = (const float*)(c.ws + WS_ROPE);
    const unsigned long long* MASK = (const unsigned long long*)(c.ws + WS_MASK); bf16_t* YB = (bf16_t*)(c.ws + WS_YBUF);
    const int tid = c.tid, lane = c.lane, r32 = lane & 31, hi = lane >> 5, wid = c.wave;
    const int q0 = qb * 256, qw = q0 + 64 * ((wid >> 1) ^ (wid >> 2)) + 32 * (wid & 1), qglob = qw + r32; const size_t mrow = (size_t)b * SEQ + qglob;
    const int NT = 4 * (qb + 1), tmax = qw >> 6;
    const float cs = (MLA ? 0.10206207261596575f : 0.125f) * LOG2E;
    LAS unsigned char* lds = c.lds;
    const int dkey = 8 * wid + (lane >> 3), dpos = lane & 7;
    const int kchunk = dpos ^ ((dkey >> 1) & 7), vchunk = dpos ^ (((dkey >> 1) & 1) << 2);
    const char *ksrc, *vsrc, *xsrc; size_t tstepK, tstepX;
    if constexpr (MLA) { const bf16_t* rowp = UPO + ((size_t)b * SEQ + dkey) * UPO_LD + 768 + 128 * h; ksrc = (const char*)(rowp + 8 * kchunk); vsrc = (const char*)(rowp + 64 + 8 * vchunk);
        const int xkey = 16 * (wid & 3) + (lane >> 2), xpos = lane & 3;
        xsrc = (const char*)(KRB + ((size_t)b * SEQ + xkey) * 32 + 8 * (xpos ^ ((xkey >> 2) & 3))); tstepK = (size_t)64 * UPO_LD * 2; tstepX = 64 * 32 * 2; }
    else { const bf16_t* rowp = PROJ + ((size_t)b * SEQ + dkey) * D_INP + 64 * h; ksrc = (const char*)(rowp + PC_KA + 8 * kchunk); vsrc = (const char*)(rowp + PC_VA + 8 * vchunk);
        xsrc = (const char*)(MASK + mrow * 32); tstepK = (size_t)64 * D_INP * 2; tstepX = 8; }
    const unsigned wbase = (unsigned)wid * 1024u;
#define A_DMA(t) do { const int t_ = (t); const unsigned so_ = (unsigned)(t_ & 3) * SLOTB; \
        __builtin_amdgcn_global_load_lds((const unsigned*)(ksrc + (size_t)t_ * tstepK), (LAS unsigned*)(lds + so_ + wbase), 16, 0, 0); \
        __builtin_amdgcn_global_load_lds((const unsigned*)(vsrc + (size_t)t_ * tstepK), (LAS unsigned*)(lds + so_ + VOFF + wbase), 16, 0, 0); \
        if constexpr (MLA) { if (wid < 4) __builtin_amdgcn_global_load_lds((const unsigned*)(xsrc + (size_t)t_ * tstepX), (LAS unsigned*)(lds + so_ + XOFF + wbase), 16, 0, 0); } \
        else { __builtin_amdgcn_global_load_lds((const unsigned*)(xsrc + (size_t)t_ * tstepX), (LAS unsigned*)(lds + so_ + XOFF + (unsigned)wid * 512u), 4, 0, 0); \
               __builtin_amdgcn_global_load_lds((const unsigned*)(xsrc + (size_t)t_ * tstepX + 4), (LAS unsigned*)(lds + so_ + XOFF + (unsigned)wid * 512u + 256u), 4, 0, 0); } } while (0)
#define A_WAITBAR(n_) do { if constexpr (!MLA) { if ((n_) == 2) asm volatile("s_waitcnt vmcnt(8)" ::: "memory"); else if ((n_) == 1) asm volatile("s_waitcnt vmcnt(4)" ::: "memory"); else asm volatile("s_waitcnt vmcnt(0)" ::: "memory"); } \
        else if (wid < 4) { if ((n_) == 2) asm volatile("s_waitcnt vmcnt(6)" ::: "memory"); else if ((n_) == 1) asm volatile("s_waitcnt vmcnt(3)" ::: "memory"); else asm volatile("s_waitcnt vmcnt(0)" ::: "memory"); } \
        else { if ((n_) == 2) asm volatile("s_waitcnt vmcnt(4)" ::: "memory"); else if ((n_) == 1) asm volatile("s_waitcnt vmcnt(2)" ::: "memory"); else asm volatile("s_waitcnt vmcnt(0)" ::: "memory"); } \
        __builtin_amdgcn_s_barrier(); asm volatile("" ::: "memory"); } while (0)
    A_DMA(0); A_DMA(1);
    bf16x8 qr[NKS];
    {
        const bf16_t* qrow = MLA ? UPO + mrow * UPO_LD + 96 * h : PROJ + mrow * D_INP + PC_QA + 64 * h;
        u32x4 wq[4], w1 = {0u, 0u, 0u, 0u}, w2 = {0u, 0u, 0u, 0u}; f32x4 c0 = {}, c1 = {}, s0 = {}, s1 = {};
#pragma unroll
        for (int j = 0; j < 4; ++j) wq[j] = *(const u32x4*)(qrow + 16 * j + 8 * hi);
        if constexpr (MLA) { w1 = *(const u32x4*)(qrow + 64 + 8 * hi); w2 = *(const u32x4*)(qrow + 80 + 8 * hi);
            const float* rp = ROPE + mrow * 32 + 8 * hi; c0 = *(const f32x4*)(rp); c1 = *(const f32x4*)(rp + 4); s0 = *(const f32x4*)(rp + 16); s1 = *(const f32x4*)(rp + 20); }
        float c15v = 0.f, lutv = 0.f;
        if constexpr (!MLA) { c15v = rel_bias[15 * 8 + h];
            if (tid < 255) { const int rel = tid - 191; const int n = rel < 0 ? -rel : rel;
                int bk = n < 8 ? n : (n < 12 ? 8 : (n < 16 ? 9 : (n < 23 ? 10 : (n < 32 ? 11 : (n < 46 ? 12 : (n < 64 ? 13 : (n < 91 ? 14 : 15)))))));
                if (rel > 0) bk += 16;
                lutv = rel_bias[bk * 8 + h]; } }
        asm volatile("s_waitcnt vmcnt(0)" ::: "memory");
#pragma unroll
        for (int j = 0; j < 4; ++j) { const u32x4 w = wq[j]; u32x4 o;
            o.x = cvtpk(bflo(w.x) * cs, bfhi(w.x) * cs); o.y = cvtpk(bflo(w.y) * cs, bfhi(w.y) * cs); o.z = cvtpk(bflo(w.z) * cs, bfhi(w.z) * cs); o.w = cvtpk(bflo(w.w) * cs, bfhi(w.w) * cs);
            qr[j] = __builtin_bit_cast(bf16x8, o); }
        if constexpr (MLA) {
            float x1[8] = {bflo(w1.x), bfhi(w1.x), bflo(w1.y), bfhi(w1.y), bflo(w1.z), bfhi(w1.z), bflo(w1.w), bfhi(w1.w)};
            float x2[8] = {bflo(w2.x), bfhi(w2.x), bflo(w2.y), bfhi(w2.y), bflo(w2.z), bfhi(w2.z), bflo(w2.w), bfhi(w2.w)};
            float y1[8], y2[8];
#pragma unroll
            for (int e = 0; e < 8; ++e) { const float cc = e < 4 ? c0[e & 3] : c1[e & 3], ss = e < 4 ? s0[e & 3] : s1[e & 3];
                y1[e] = (x1[e] * cc - x2[e] * ss) * cs; y2[e] = (x2[e] * cc + x1[e] * ss) * cs; }
            u32x4 o1, o2; o1.x = cvtpk(y1[0], y1[1]); o1.y = cvtpk(y1[2], y1[3]); o1.z = cvtpk(y1[4], y1[5]); o1.w = cvtpk(y1[6], y1[7]);
            o2.x = cvtpk(y2[0], y2[1]); o2.y = cvtpk(y2[2], y2[3]); o2.z = cvtpk(y2[4], y2[5]); o2.w = cvtpk(y2[6], y2[7]);
            qr[4] = __builtin_bit_cast(bf16x8, o1); qr[5] = __builtin_bit_cast(bf16x8, o2);
        } else {
            if (tid < 255) ((LAS float*)(lds + LUTOFF))[tid] = lutv * LOG2E;
        }
        c15v *= LOG2E;
        float M = 0.f, lrun = 0.f; bool fresh = true; f32x16 o0 = {}, o1 = {};
        const bf16x8 kx = __builtin_bit_cast(bf16x8, (u32x4){hi == 0 ? 0x3f80u : 0u, 0u, 0u, 0u}); bf16x8 qx = __builtin_bit_cast(bf16x8, (u32x4){0u, 0u, 0u, 0u});
        int kfo[NKS];
#pragma unroll
        for (int j = 0; j < NKS; ++j) kfo[j] = (MLA && j >= 4) ? XOFF + r32 * 64 + (((2 * (j - 4) + hi) ^ ((r32 >> 2) & 3)) << 4) : r32 * 128 + (((2 * j + hi) ^ ((r32 >> 1) & 7)) << 4);
        const int vq = (lane & 15) >> 2, vf = ((vq >> 1) & 1) << 2;
        const int vfo0 = VOFF + (4 * hi + vq) * 128 + ((0 ^ vf) << 4) + ((lane >> 4) & 1) * 32 + (lane & 3) * 8;
        const int vfo1 = VOFF + (4 * hi + vq) * 128 + ((4 ^ vf) << 4) + ((lane >> 4) & 1) * 32 + (lane & 3) * 8;
        for (int t = 0; t < NT; ++t) {
            if (t + 2 < NT) { A_DMA(t + 2); A_WAITBAR(2); } else if (t + 1 < NT) { A_WAITBAR(1); } else { A_WAITBAR(0); }
            if (t <= tmax) {
                const LAS unsigned char* sl = lds + (t & 3) * SLOTB;
                f32x16 s0v, s1v;
                if constexpr (!MLA) {
                    if (64 * t > qw - 154) { const LAS float* lut = (const LAS float*)(lds + LUTOFF); const int base = 64 * t - qglob + 191 + 4 * hi;
#pragma unroll
                        for (int r = 0; r < 16; ++r) { const int o = base + (r & 3) + 8 * (r >> 2); s0v[r] = lut[o]; s1v[r] = lut[o + 32]; } }
                    else {
#pragma unroll
                        for (int r = 0; r < 16; ++r) { s0v[r] = c15v; s1v[r] = c15v; } }
                } else {
#pragma unroll
                    for (int r = 0; r < 16; ++r) { s0v[r] = 0.f; s1v[r] = 0.f; }
                }
                bf16x8 kfa[NKS], kfb[NKS];
#pragma unroll
                for (int j = 0; j < NKS; ++j) { kfa[j] = *(const LAS bf16x8*)(sl + kfo[j]); kfb[j] = *(const LAS bf16x8*)(sl + kfo[j] + ((MLA && j >= 4) ? 2048 : 4096)); }
                __builtin_amdgcn_sched_barrier(0);
#pragma unroll
                for (int j = 0; j < NKS; ++j) { s0v = __builtin_amdgcn_mfma_f32_32x32x16_bf16(kfa[j], qr[j], s0v, 0, 0, 0); s1v = __builtin_amdgcn_mfma_f32_32x32x16_bf16(kfb[j], qr[j], s1v, 0, 0, 0); }
                s0v = __builtin_amdgcn_mfma_f32_32x32x16_bf16(kx, qx, s0v, 0, 0, 0); s1v = __builtin_amdgcn_mfma_f32_32x32x16_bf16(kx, qx, s1v, 0, 0, 0);
                s16x4 vlo[8], vhi[8]; { const unsigned va0_ = (unsigned)(size_t)(sl + vfo0), va1_ = (unsigned)(size_t)(sl + vfo1);
#pragma unroll
                    for (int i = 0; i < 4; ++i) { asm volatile("ds_read_b64_tr_b16 %0, %1 offset:%2" : "=&v"(vlo[i]) : "v"(va0_), "n"(i * 2048) : "memory");
                        asm volatile("ds_read_b64_tr_b16 %0, %1 offset:%2" : "=&v"(vhi[i]) : "v"(va0_), "n"(i * 2048 + 1024) : "memory");
                        asm volatile("ds_read_b64_tr_b16 %0, %1 offset:%2" : "=&v"(vlo[4 + i]) : "v"(va1_), "n"(i * 2048) : "memory");
                        asm volatile("ds_read_b64_tr_b16 %0, %1 offset:%2" : "=&v"(vhi[4 + i]) : "v"(va1_), "n"(i * 2048 + 1024) : "memory"); } }
                if constexpr (!MLA) { const LAS unsigned* mw = (const LAS unsigned*)(sl + XOFF + wid * 512 + r32 * 4);
                    const unsigned wl = mw[0] >> (4 * hi), wh = mw[64] >> (4 * hi);
#pragma unroll
                    for (int r = 0; r < 16; ++r) { const int bit = (r & 3) + 8 * (r >> 2);
                        const unsigned t0 = (unsigned)__builtin_amdgcn_sbfe((int)wl, bit, 1), t1 = (unsigned)__builtin_amdgcn_sbfe((int)wh, bit, 1);
                        s0v[r] = __uint_as_float((__float_as_uint(s0v[r]) & t0) | (0xff800000u & ~t0)); s1v[r] = __uint_as_float((__float_as_uint(s1v[r]) & t1) | (0xff800000u & ~t1)); } }
                float mx;
                { float ma, mb;
#define MAX3(d, a, b, c) asm("v_max3_f32 %0, %1, %2, %3" : "=v"(d) : "v"(a), "v"(b), "v"(c))
                  asm("s_nop 15\n\ts_nop 3\n\tv_max3_f32 %0, %2, %3, %4\n\tv_max3_f32 %1, %5, %6, %7" : "=&v"(ma), "=&v"(mb) : "v"(s0v[0]), "v"(s0v[1]), "v"(s0v[2]), "v"(s1v[0]), "v"(s1v[1]), "v"(s1v[2]));
#pragma unroll
                  for (int r = 3; r < 15; r += 2) { MAX3(ma, ma, s0v[r], s0v[r + 1]); MAX3(mb, mb, s1v[r], s1v[r + 1]); }
                  MAX3(ma, ma, mb, s0v[15]); MAX3(mx, ma, s1v[15], s1v[15]);
#undef MAX3
                }
                mx = xor32_max(mx);
                {
                    const bool finite = mx > -INFINITY; const bool upd = finite && (mx > 8.f || fresh);
                    if (__builtin_amdgcn_ballot_w64(upd) != 0ull) {
                        const float Mx = M + mx; const unsigned ub = __float_as_uint(Mx);
                        const float Mn = upd ? __uint_as_float(Mx >= 0.f ? ((ub + 0xffffu) & 0xffff0000u) : (ub & 0xffff0000u)) : M;
                        const float delta = Mn - M; const float alpha = fresh ? 0.f : __builtin_amdgcn_exp2f(-delta);
                        M = Mn; lrun *= alpha;
#pragma unroll
                        for (int r = 0; r < 16; ++r) { o0[r] *= alpha; o1[r] *= alpha; s0v[r] -= delta; s1v[r] -= delta; }
                        qx = __builtin_bit_cast(bf16x8, (u32x4){hi == 0 ? ((__float_as_uint(M) ^ 0x80000000u) >> 16) : 0u, 0u, 0u, 0u});
                    }
                    fresh = fresh && !finite;
                }
                float ls = 0.f;
#pragma unroll
                for (int r = 0; r < 16; ++r) { s0v[r] = __builtin_amdgcn_exp2f(s0v[r]); s1v[r] = __builtin_amdgcn_exp2f(s1v[r]); ls += s0v[r] + s1v[r]; }
                lrun += ls;
                bf16x8 pf[4];
                { u32x4 w;
                  w.x = cvtpk(s0v[0], s0v[1]); w.y = cvtpk(s0v[2], s0v[3]); w.z = cvtpk(s0v[4], s0v[5]); w.w = cvtpk(s0v[6], s0v[7]); pf[0] = __builtin_bit_cast(bf16x8, w);
                  w.x = cvtpk(s0v[8], s0v[9]); w.y = cvtpk(s0v[10], s0v[11]); w.z = cvtpk(s0v[12], s0v[13]); w.w = cvtpk(s0v[14], s0v[15]); pf[1] = __builtin_bit_cast(bf16x8, w);
                  w.x = cvtpk(s1v[0], s1v[1]); w.y = cvtpk(s1v[2], s1v[3]); w.z = cvtpk(s1v[4], s1v[5]); w.w = cvtpk(s1v[6], s1v[7]); pf[2] = __builtin_bit_cast(bf16x8, w);
                  w.x = cvtpk(s1v[8], s1v[9]); w.y = cvtpk(s1v[10], s1v[11]); w.z = cvtpk(s1v[12], s1v[13]); w.w = cvtpk(s1v[14], s1v[15]); pf[3] = __builtin_bit_cast(bf16x8, w); }
                asm volatile("s_waitcnt lgkmcnt(0)" : "+v"(vlo[0]), "+v"(vlo[1]), "+v"(vlo[2]), "+v"(vlo[3]), "+v"(vlo[4]), "+v"(vlo[5]), "+v"(vlo[6]), "+v"(vlo[7]),
                             "+v"(vhi[0]), "+v"(vhi[1]), "+v"(vhi[2]), "+v"(vhi[3]), "+v"(vhi[4]), "+v"(vhi[5]), "+v"(vhi[6]), "+v"(vhi[7]) :: "memory");
#pragma unroll
                for (int ks = 0; ks < 4; ++ks) {
                    const bf16x8 va = __builtin_shufflevector(vlo[ks], vhi[ks], 0, 1, 2, 3, 4, 5, 6, 7), vb = __builtin_shufflevector(vlo[4 + ks], vhi[4 + ks], 0, 1, 2, 3, 4, 5, 6, 7);
                    o0 = __builtin_amdgcn_mfma_f32_32x32x16_bf16(va, pf[ks], o0, 0, 0, 0);
                    o1 = __builtin_amdgcn_mfma_f32_32x32x16_bf16(vb, pf[ks], o1, 0, 0, 0);
                }
            }
        }
        lrun = xor32_sum(lrun);
        const float inv = 1.0f / lrun;
        unsigned char* yrow = (unsigned char*)YB + mrow * DM + (MLA ? 512 : 0) + 64 * h + 4 * hi;
        const float ys = inv * Y_SCALE;
#pragma unroll
        for (int g = 0; g < 4; ++g) {
            *(unsigned*)(yrow + 8 * g) = pk4_fp8(o0[4 * g] * ys, o0[4 * g + 1] * ys, o0[4 * g + 2] * ys, o0[4 * g + 3] * ys);
            *(unsigned*)(yrow + 32 + 8 * g) = pk4_fp8(o1[4 * g] * ys, o1[4 * g + 1] * ys, o1[4 * g + 2] * ys, o1[4 * g + 3] * ys); }
    }
    asm volatile("s_waitcnt vmcnt(0) lgkmcnt(0)" ::: "memory"); __builtin_amdgcn_s_barrier(); asm volatile("" ::: "memory");
#undef A_DMA
#undef A_WAITBAR
}
DI void phase_attention(KP p, const Ctx& c) {
    for (int v = c.vcu; v < 256; v += c.G) { const int bh = v >> 2, s = v & 3, b = bh >> 3, h = bh & 7;
        for (int rep_ = 0; rep_ < (PROBE_X == 4 ? 2 : 1); ++rep_) attn_unit<false>(c, p->rel_bias, b, h, 7 - s);
        for (int rep_ = 0; rep_ < (PROBE_X == 5 ? 2 : 1); ++rep_) attn_unit<true>(c, p->rel_bias, b, h, 7 - s);
        for (int rep_ = 0; rep_ < (PROBE_X == 4 ? 2 : 1); ++rep_) attn_unit<false>(c, p->rel_bias, b, h, s);
        for (int rep_ = 0; rep_ < (PROBE_X == 5 ? 2 : 1); ++rep_) attn_unit<true>(c, p->rel_bias, b, h, s); }
}

DI void phase_router(KP p, const Ctx& c, int layer) {
    const bf16_t* XR = (const bf16_t*)(c.ws + WS_XR); unsigned char* HB8 = c.ws + WS_XP8; const float* MODS = (const float*)(c.ws + WS_MODS);
    int* ME = (int*)(c.ws + WS_ME); int* MR = (int*)(c.ws + WS_MR); float* MG = (float*)(c.ws + WS_MG);
    unsigned* gcnt = (unsigned*)(c.ws + WS_CTL) + CW_GCNT + layer * 64;
    constexpr int HS_LD = 1025;
    LAS float* hs = (LAS float*)c.lds;
    LAS float* red = (LAS float*)c.lds;
    LAS float* logit = (LAS float*)(c.lds + 34816);
    LAS int* lcnt = (LAS int*)(c.lds + LC_MISC);
    const float* wr_ = p->w_router + (size_t)layer * 1024 * 32; const float* br_ = p->b_router + layer * 32;
    const int r32 = c.lane & 31, hi = c.lane >> 5;
    bf16x8 wh[8], wl[8];
    { float wv[64];
#pragma unroll
      for (int kk = 0; kk < 64; ++kk) wv[kk] = wr_[(c.wave * 128 + 16 * (kk >> 3) + 8 * hi + (kk & 7)) * 32 + r32];
#pragma unroll
      for (int ks = 0; ks < 8; ++ks) { u32x4 oh, ol;
#pragma unroll
          for (int q = 0; q < 4; ++q) { const float x0 = wv[8 * ks + 2 * q], x1 = wv[8 * ks + 2 * q + 1];
              const unsigned h0 = __float_as_uint(x0) & 0xffff0000u, h1 = __float_as_uint(x1) & 0xffff0000u;
              oh[q] = h1 | (h0 >> 16); ol[q] = cvtpk(x0 - __uint_as_float(h0), x1 - __uint_as_float(h1)); }
          wh[ks] = __builtin_bit_cast(bf16x8, oh); wl[ks] = __builtin_bit_cast(bf16x8, ol); } }
    for (int blk = c.vcu; blk < NTOK / 64; blk += c.G) {
        if (c.tid < 32) lcnt[c.tid] = 0;
        __syncthreads();
        for (int grp = 0; grp < 2; ++grp) {
            const int m0 = blk * 64 + grp * 32;
            { f32x4 v[4][4];
#pragma unroll
              for (int i = 0; i < 4; ++i) load_row_bf(XR + (size_t)(m0 + c.wave * 4 + i) * DM, c.lane, v[i]);
#pragma unroll
              for (int i = 0; i < 4; ++i) { const int tl = c.wave * 4 + i, m = m0 + tl, b = m >> 11; f32x4 h[4];
                const float r = row_rinv(v[i], c.lane);
                const float* md = MODS + (layer * 8 + b) * 6144 + 3 * 1024;
                modulate(v[i], r, p->norm_ffn + layer * 1024, md, md + 1024, c.lane, h);
#pragma unroll
                for (int j = 0; j < 4; ++j) *(unsigned*)(HB8 + (size_t)m * DM + 4 * c.lane + 256 * j) = pk4_fp8(h[j][0] * X_SCALE, h[j][1] * X_SCALE, h[j][2] * X_SCALE, h[j][3] * X_SCALE);
#pragma unroll
                for (int j = 0; j < 4; ++j)
#pragma unroll
                    for (int e = 0; e < 4; ++e) hs[tl * HS_LD + 4 * c.lane + 256 * j + e] = h[j][e]; } }
            __syncthreads();
            f32x16 acc = {};
#pragma unroll
            for (int ks = 0; ks < 8; ++ks) { const LAS float* xr = hs + r32 * HS_LD + c.wave * 128 + 16 * ks + 8 * hi; u32x4 oh, ol;
#pragma unroll
                for (int q = 0; q < 4; ++q) { const float x0 = xr[2 * q], x1 = xr[2 * q + 1];
                    const unsigned h0 = __float_as_uint(x0) & 0xffff0000u, h1 = __float_as_uint(x1) & 0xffff0000u;
                    oh[q] = h1 | (h0 >> 16); ol[q] = cvtpk(x0 - __uint_as_float(h0), x1 - __uint_as_float(h1)); }
                const bf16x8 ah = __builtin_bit_cast(bf16x8, oh), al = __builtin_bit_cast(bf16x8, ol);
                acc = __builtin_amdgcn_mfma_f32_32x32x16_bf16(ah, wh[ks], acc, 0, 0, 0);
                acc = __builtin_amdgcn_mfma_f32_32x32x16_bf16(ah, wl[ks], acc, 0, 0, 0);
                acc = __builtin_amdgcn_mfma_f32_32x32x16_bf16(al, wh[ks], acc, 0, 0, 0); }
            __syncthreads();
#pragma unroll
            for (int r = 0; r < 16; ++r) red[(c.wave * 32 + crow(r, hi)) * 33 + r32] = acc[r];
            __syncthreads();
            for (int i = c.tid; i < 1024; i += 512) { const int tk = i >> 5, e = i & 31; float s = br_[e];
#pragma unroll
                for (int w = 0; w < 8; ++w) s += red[(w * 32 + tk) * 33 + e];
                logit[tk * 33 + e] = s; }
            __syncthreads();
            if (c.tid < 32) { const int m = m0 + c.tid; const LAS float* lg = logit + c.tid * 33; float tv[4]; int te[4]; float x[32];
#pragma unroll
                for (int e = 0; e < 32; ++e) x[e] = lg[e];
#pragma unroll
                for (int k = 0; k < 4; ++k) { float best = x[0]; int be = 0;
#pragma unroll
                    for (int e = 1; e < 32; ++e) { if (x[e] > best) { best = x[e]; be = e; } }
#pragma unroll
                    for (int e = 0; e < 32; ++e) x[e] = (e == be) ? -INFINITY : x[e];
                    tv[k] = best; te[k] = be; }
                float gs = 0.f, gv[4];
#pragma unroll
                for (int k = 0; k < 4; ++k) { gv[k] = __expf(tv[k] - tv[0]); gs += gv[k]; }
#pragma unroll
                for (int k = 0; k < 4; ++k) { ME[m * 4 + k] = te[k]; MG[m * 4 + k] = gv[k] / gs; MR[m * 4 + k] = atomicAdd((int*)&lcnt[te[k]], 1); } }
            __syncthreads();
        }
        if (c.tid < 32) lcnt[32 + c.tid] = (int)atomicAdd(&gcnt[c.tid], (unsigned)lcnt[c.tid]);
        __syncthreads();
        if (c.tid < 256) { const int m = blk * 64 + (c.tid >> 2), k = c.tid & 3; const int e = ME[m * 4 + k]; const int rk = MR[m * 4 + k] + lcnt[32 + e]; MR[m * 4 + k] = rk; ((int*)(c.ws + WS_RANKTOK))[e * 16384 + rk] = m; }
        __syncthreads();
    }
}
constexpr int NPHASE = 20;
DI void refresh(Ctx& c, KP& p) {
    asm volatile("" : "+s"(p));
    int w_id = c.wave, z_ = 0; asm volatile("" : "+s"(w_id), "+v"(z_));
    c.wave = w_id; c.lane = (int)__builtin_amdgcn_mbcnt_hi(~0u, __builtin_amdgcn_mbcnt_lo(~0u, (unsigned)z_)); c.tid = w_id * 64 + c.lane;
    int g_ = gridDim.x, b_ = blockIdx.x; asm volatile("" : "+s"(g_), "+s"(b_)); c.G = g_; c.bx = b_;
    c.vcu = (g_ % 8 == 0) ? (b_ % 8) * (g_ / 8) + b_ / 8 : b_;
    c.gw = c.vcu * 8 + c.wave; c.NGW = g_ * 8;
    if (g_ == 256) { c.rbase = (c.vcu >> 5) * SEQ; c.rcnt = SEQ; c.lw = (c.vcu & 31) * 8 + c.wave; c.NLW = 256; } else { c.rbase = 0; c.rcnt = NTOK; c.lw = c.gw; c.NLW = c.NGW; }
    unsigned char* w_ = p->ws; asm volatile("" : "+s"(w_)); c.ws = w_;
    unsigned l_ = 0u; asm volatile("" : "+s"(l_)); c.lds = (LAS unsigned char*)(uintptr_t)l_;
}
template <int PH> DI void run_phase(KP p, const Ctx& c) {
    if constexpr (PH == 0) phase_prologue(p, c);
    else if constexpr (PH == NPHASE - 1) phase_final(p, c);
    else {
        constexpr int layer = (PH - 1) / 9, sub = (PH - 1) % 9;
        if constexpr (sub == 0) phase_norm_mix(p, c, layer);
        else if constexpr (sub == 1) {
            { SchedDense S{(const char*)(c.ws + WS_H8IN), (const char*)(c.ws + WS_WIN8) + (size_t)layer * D_INP * 1024, NTOK / 256, D_INP / 256, c.G, c.bx, (size_t)256 * 1024, layer != 0};
              EpiProj E{(bf16_t*)(c.ws + WS_PROJ), D_INP, 1.0f / (X_SCALE * W_SCALE)}; pg8::gemm_phase<true, false>(c.lds, c.tid, 512, S, E); }
            if constexpr (layer == 0) {
                if (c.bx >= 128) { __syncthreads(); big_convert(p, c, c.bx - 128, 128, SLOT_IN, BIG_ND, 0, BIG_L1); } } }
        else if constexpr (sub == 2) phase_prep_indexer(p, c, layer);
        else if constexpr (sub == 3) { SchedUp S{(const char*)(c.ws + WS_CQN), (const char*)(c.ws + WS_WUP) + (size_t)layer * 1792 * 256, c.G, c.bx};
            EpiProj E{(bf16_t*)(c.ws + WS_UPO), UPO_LD, 1.0f / (X_SCALE * W_SCALE)}; pg8::gemm_phase<true, false>(c.lds, c.tid, 128, S, E); }
        else if constexpr (sub == 4) phase_attention(p, c);
        else if constexpr (sub == 5) { SchedDense S{(const char*)(c.ws + WS_YBUF), (const char*)(c.ws + WS_WOUT) + (size_t)layer * 1024 * 1024, NTOK / 256, 4, c.G, c.bx, (size_t)256 * 1024};
            EpiOut<layer == 0> E{(bf16_t*)(c.ws + WS_XR), p->x, (const float*)(c.ws + WS_MODS) + layer * 8 * 6144 + 2 * 1024, 1.0f / (Y_SCALE * W_SCALE)}; pg8::gemm_phase<true, false>(c.lds, c.tid, 512, S, E); }
        else if constexpr (sub == 6) { phase_router(p, c, layer);
            if constexpr (layer == DEPTH - 1) { __syncthreads(); const int base = *(const LAS int*)(c.lds + LC_DEFER);
                big_convert(p, c, base + c.vcu, c.G, 1 << 20, BIG_ND, 0, BIG_L1); } }
        else if constexpr (sub == 7) {
            const int nt = build_tiles(c, layer);
            const LAS int* pst = (const LAS int*)(c.lds + LC_PST); const LAS int* tile_e = (const LAS int*)(c.lds + LC_TILEE); const LAS int* cnt = (const LAS int*)(c.lds + LC_CNT);
            LAS int* rowtab = (LAS int*)(c.lds + RT_OFF); const int* RANKTOK = (const int*)(c.ws + WS_RANKTOK);
            SchedMoeG S{(const char*)(c.ws + WS_XP8), (const char*)(c.ws + WS_W1) + (size_t)layer * 32 * 2048 * 1024, tile_e, rowtab, nt, 8, c.G, c.bx, layer != 0};
            { int tok[9];
#pragma unroll
              for (int i = 0; i < 9; ++i) { Unit u; tok[i] = -1; if (c.tid < 256 && S.next(i, u)) { const int e = tile_e[u.pm]; const int rk = (u.pm - pst[e]) * 256 + c.tid; tok[i] = rk < cnt[e] ? RANKTOK[e * 16384 + rk] : 0; } }
#pragma unroll
              for (int i = 0; i < 9; ++i) if (tok[i] >= 0) rowtab[i * 256 + c.tid] = tok[i] * 1024; }
            __syncthreads();
            EpiSwiglu E{c.ws + WS_HID8, p->b1 + (size_t)layer * 32 * 2048, tile_e}; pg8::gemm_phase<true, true>(c.lds, c.tid, 512, S, E);
            if constexpr (layer == 0) { int rx, nidx, before, nid;
                if (c.G == 256) pg8::moe_idle(nt, 8, c.bx & 7, rx, nidx, before, nid); else { rx = (nt * 8) % c.G; nid = rx ? c.G - rx : 0; before = 0; }
                const int rank = c.G == 256 ? (c.bx >> 3) : c.bx;
                if (rx && rank >= rx) { __syncthreads(); big_convert(p, c, 128 * SLOT_IN + before + (rank - rx), nid, SLOT_MOE, BIG_ND, 0, BIG_L1); }
                if (c.tid == 0) *(LAS int*)(c.lds + LC_DEFER) = 128 * SLOT_IN + SLOT_MOE * nid; } }
        else { const int nt = reuse_tiles(c, layer);
            SchedMoe S{(const char*)(c.ws + WS_HID8), (const char*)(c.ws + WS_W2) + (size_t)layer * 32 * 1024 * 1024, (const LAS int*)(c.lds + LC_TILEE), nt, 4, c.G, c.bx, layer != 0};
            EpiDown E{c.ws + WS_YEXP, p->b2 + (size_t)layer * 32 * 1024, (const LAS int*)(c.lds + LC_TILEE)}; pg8::gemm_phase<true, false>(c.lds, c.tid, 512, S, E);
            if constexpr (layer == 0) { int rx, nidx, before, nid; const int base = *(const LAS int*)(c.lds + LC_DEFER);
                if (c.G == 256) pg8::moe_idle(nt, 4, c.bx & 7, rx, nidx, before, nid); else { rx = (nt * 4) % c.G; nid = rx ? c.G - rx : 0; before = 0; }
                const int rank = c.G == 256 ? (c.bx >> 3) : c.bx;
                __syncthreads();
                if (rx && rank >= rx) big_convert(p, c, base + before + (rank - rx), nid, SLOT_MOE, BIG_ND, 0, BIG_L1);
                if (c.tid == 0) *(LAS int*)(c.lds + LC_DEFER) = base + SLOT_MOE * nid; } }
    }
}
__global__ void __launch_bounds__(512, 2) fwd_kernel(P p_arg, int ph_lo, int ph_hi) {
    extern __shared__ __attribute__((aligned(16))) unsigned char lds_raw[];
    KP p = (KP)__builtin_amdgcn_kernarg_segment_ptr();
    Ctx c; c.wave = __builtin_amdgcn_readfirstlane((int)threadIdx.x >> 6); refresh(c, p);
    for (int u = c.tid; u < (LDS_BYTES - LC_OFF) / 4; u += 512) ((LAS unsigned*)(c.lds + LC_OFF))[u] = 0u;
    __syncthreads();
#if !MULTI_LAUNCH
    XcdBarrier bar = xcd_barrier_post((unsigned*)(c.ws + WS_CTL) + CW_BAR, (volatile LAS unsigned*)(c.lds + LC_BARST), c.tid);
    if (c.tid == 0 && (bar.x != (unsigned)(c.bx & 7) || c.G != 256)) (void)xb_add((unsigned*)(c.ws + WS_CTL) + CW_MISMATCH, 1u);
#define SEAM_LOCAL(k) ((k) >= 1 && (k) < NPHASE - 1 && (((k) - 1) % 9 <= 5 || ((k) - 1) % 9 == 7))
#define SEAM(k) do { if ((k) + 1 < ph_hi) { xcd_barrier(bar, c.tid, SEAM_LOCAL(k)); \
        if ((k) == 0 && c.tid == 0) bar.st[2] = (xb_ld((unsigned*)(c.ws + WS_CTL) + CW_MISMATCH) == 0u) ? 1u : 0u; } } while (0)
#else
#define SEAM(k) do { } while (0)
#endif
#ifndef DBL_MASK
#define DBL_MASK 0u
#endif
#if MULTI_LAUNCH
#define REDO(k) do { } while (0)
#else
#define REDO(k) do { if constexpr (((DBL_MASK) >> (k)) & 1u) { xcd_barrier(bar, c.tid); refresh(c, p); run_phase<k>(p, c); } } while (0)
#endif
#define RUN(k) do { if (ph_lo <= (k) && (k) < ph_hi) { refresh(c, p); run_phase<k>(p, c); REDO(k); SEAM(k); } } while (0)
    RUN(0); RUN(1); RUN(2); RUN(3); RUN(4); RUN(5); RUN(6); RUN(7); RUN(8); RUN(9); RUN(10);
    RUN(11); RUN(12); RUN(13); RUN(14); RUN(15); RUN(16); RUN(17); RUN(18); RUN(19);
#undef RUN
#undef SEAM
}

extern "C" void kernel_launch(void* const* d_in, const int* in_sizes, int n_in, void* d_out, int out_size, void* d_ws, size_t ws_size, hipStream_t stream) {
    static int ready = 0;
    if (!ready) {
        if (n_in != 21 || ws_size < WS_END || out_size != NTOK * DM) { fprintf(stderr, "kernel_launch: unexpected shapes (n_in %d, ws %zu, out %d)\n", n_in, ws_size, out_size); ready = -1; return; }
        if (hipFuncSetAttribute((const void*)fwd_kernel, hipFuncAttributeMaxDynamicSharedMemorySize, LDS_BYTES) != hipSuccess) { fprintf(stderr, "kernel_launch: hipFuncSetAttribute failed\n"); ready = -1; return; }
        int per_cu = 0; (void)hipOccupancyMaxActiveBlocksPerMultiprocessor(&per_cu, (const void*)fwd_kernel, 512, LDS_BYTES); (void)hipGetLastError();
        if (per_cu < 1) { fprintf(stderr, "kernel_launch: occupancy query says %d workgroups per CU; the grid barrier needs every workgroup resident; nothing launched\n", per_cu); ready = -1; return; }
        ready = 1;
    }
    if (ready < 0) return;
    (void)hipMemsetAsync((char*)d_ws + WS_CTL, 0, CTL_BYTES, stream);
    P p{};
    p.x = (const float*)d_in[0]; p.c = (const float*)d_in[1]; p.pos = (const int*)d_in[2]; p.rel_bias = (const float*)d_in[3]; p.norm_mix = (const float*)d_in[4];
    p.w_ada = (const float*)d_in[5]; p.b_ada = (const float*)d_in[6]; p.w_in = (const float*)d_in[7]; p.q_norm = (const float*)d_in[8]; p.w_uq = (const float*)d_in[9];
    p.kv_norm = (const float*)d_in[10]; p.w_ukv = (const float*)d_in[11]; p.w_out = (const float*)d_in[12]; p.norm_ffn = (const float*)d_in[13]; p.w_router = (const float*)d_in[14];
    p.b_router = (const float*)d_in[15]; p.w1 = (const float*)d_in[16]; p.b1 = (const float*)d_in[17]; p.w2 = (const float*)d_in[18]; p.b2 = (const float*)d_in[19]; p.norm_final = (const float*)d_in[20];
    p.out = (float*)d_out; p.ws = (unsigned char*)d_ws;
#if MULTI_LAUNCH
    for (int ph = 0; ph < NPHASE; ++ph) hipLaunchKernelGGL(fwd_kernel, dim3(256), dim3(512), LDS_BYTES, stream, p, ph, ph + 1);
#else
    int lo = 0, hi = NPHASE; void* args[] = {&p, &lo, &hi};
    hipError_t e = hipLaunchCooperativeKernel((const void*)fwd_kernel, dim3(256), dim3(512), args, LDS_BYTES, stream);
    if (e != hipSuccess) fprintf(stderr, "cooperative launch failed: %s\n", hipGetErrorString(e));
#endif
}
```

```cpp
#include <hip/hip_runtime.h>
#include <hip/hip_cooperative_groups.h>
#include <cstdio>
#include <cstdint>
namespace cg = cooperative_groups;

#ifndef MULTI_LAUNCH
#define MULTI_LAUNCH 0
#endif

#ifndef PROBE_X
#define PROBE_X 0
#endif
#define LAS __attribute__((address_space(3)))
#define DI __device__ __forceinline__
typedef unsigned short bf16_t;
typedef short bf16x8 __attribute__((ext_vector_type(8)));
typedef short s16x4 __attribute__((ext_vector_type(4)));
typedef float f32x2 __attribute__((ext_vector_type(2)));
typedef float f32x4 __attribute__((ext_vector_type(4)));
typedef float f32x16 __attribute__((ext_vector_type(16)));
typedef unsigned u32x2 __attribute__((ext_vector_type(2)));
typedef unsigned u32x4 __attribute__((ext_vector_type(4)));
typedef __bf16 bf16x2_t __attribute__((ext_vector_type(2)));

constexpr int DM = 1024, BATCH = 8, SEQ = 2048, NTOK = BATCH * SEQ, DEPTH = 2;
constexpr int D_IN = 2536, D_INP = 2560;
constexpr int NE = 32, DEXP = 1024;
constexpr int CAP_TILES = 288, CAP_ROWS = CAP_TILES * 256;
constexpr float EPS = 1e-6f;
constexpr float LOG2E = 1.4426950408889634f;
constexpr int PC_QA = 0, PC_KA = 512, PC_VA = 1024, PC_QI = 1536, PC_KI = 2048, PC_CQ = 2112, PC_CKV = 2368, PC_KR = 2496, PC_WI = 2528;

constexpr size_t MiB = 1u << 20;
constexpr size_t WS_CTL = 0, CTL_BYTES = 64 * 1024;
constexpr size_t WS_MODS = 1 * MiB;
constexpr size_t WS_ROPE = 2 * MiB;
constexpr size_t WS_WIN = 4 * MiB;
constexpr size_t WS_WUP = 14 * MiB;
constexpr size_t WS_WOUT = 16 * MiB;
constexpr size_t WS_W1 = 20 * MiB;
constexpr size_t WS_W2 = 276 * MiB;
constexpr size_t WS_HBUF = 404 * MiB;
constexpr size_t WS_PROJ = 436 * MiB;
constexpr size_t WS_CQN = 516 * MiB;
constexpr size_t WS_CKVN = 524 * MiB;
constexpr size_t WS_KR = 532 * MiB;
constexpr size_t WS_UPO = 533 * MiB;
constexpr int UPO_LD = 1792;
constexpr size_t WS_MASK = 589 * MiB;
constexpr size_t WS_YBUF = 593 * MiB;
constexpr size_t WS_XR = 625 * MiB;
constexpr size_t WS_ME = 689 * MiB;
constexpr size_t WS_MR = 690 * MiB;
constexpr size_t WS_MG = 691 * MiB;
constexpr size_t WS_DEST = 692 * MiB;
constexpr size_t WS_YEXP = 693 * MiB;
constexpr size_t WS_XP8 = 837 * MiB;
constexpr size_t WS_WIN8 = 860 * MiB;
constexpr size_t WS_H8IN = 870 * MiB;
constexpr size_t WS_HID8 = 909 * MiB;
constexpr float W_SCALE = 64.f, X_SCALE = 8.f, H_SCALE = 4.f, Y_SCALE = 16.f, YE_SCALE = 16.f;
constexpr size_t WS_RANKTOK = 981 * MiB;
constexpr size_t WS_END = 983 * MiB;
constexpr int CW_GCNT = 64;
constexpr int CW_BAR = 4096;
constexpr int CW_MISMATCH = 32;

constexpr int SCR_BYTES = 133120;
constexpr int LC_OFF = SCR_BYTES;
constexpr int LC_BARST = LC_OFF;
constexpr int LC_PST = LC_OFF + 64;
constexpr int LC_TILEE = LC_OFF + 256;
constexpr int LC_MISC = LC_OFF + 256 + 1280;
constexpr int LC_CNT = LC_OFF + 1792;
constexpr int LC_DEFER = LC_OFF + 2048;
constexpr int SLOT_IN = 3, SLOT_MOE = 2;
constexpr int RT_OFF = SCR_BYTES + 4096;
constexpr int LDS_BYTES = RT_OFF + 9 * 1024;

struct P {
    const float *x, *c; const int* pos; const float *rel_bias, *norm_mix, *w_ada, *b_ada, *w_in, *q_norm, *w_uq, *kv_norm, *w_ukv, *w_out,
        *norm_ffn, *w_router, *b_router, *w1, *b1, *w2, *b2, *norm_final;
    float* out; unsigned char* ws;
};

typedef __attribute__((address_space(4))) const P* KP;

DI unsigned cvtpk(float lo, float hi) { f32x2 v = {lo, hi}; bf16x2_t b = __builtin_convertvector(v, bf16x2_t); return __builtin_bit_cast(unsigned, b); }
DI float clamp8(float x) { return fminf(fmaxf(x, -448.f), 448.f); }
DI unsigned pk4_fp8(float a, float b, float c, float d) { int w = 0; w = __builtin_amdgcn_cvt_pk_fp8_f32(clamp8(a), clamp8(b), w, false); w = __builtin_amdgcn_cvt_pk_fp8_f32(clamp8(c), clamp8(d), w, true); return (unsigned)w; }
DI unsigned pk4_fp8_nc(float a, float b, float c, float d) { int w = 0; w = __builtin_amdgcn_cvt_pk_fp8_f32(a, b, w, false); w = __builtin_amdgcn_cvt_pk_fp8_f32(c, d, w, true); return (unsigned)w; }
DI float bflo(unsigned u) { return __uint_as_float(u << 16); }
DI float bfhi(unsigned u) { return __uint_as_float(u & 0xffff0000u); }
DI float bf1(bf16_t h) { return __uint_as_float((unsigned)h << 16); }
DI float wave_sum(float v, int lane) {
#pragma unroll
    for (int o = 1; o < 64; o <<= 1) v += __int_as_float(__builtin_amdgcn_ds_bpermute((lane ^ o) << 2, __float_as_int(v)));
    return v;
}
DI float xor32_max(float m) { auto rr = __builtin_amdgcn_permlane32_swap(__float_as_uint(m), __float_as_uint(m), false, false); return fmaxf(__uint_as_float(rr[0]), __uint_as_float(rr[1])); }
DI float xor32_sum(float m) { auto rr = __builtin_amdgcn_permlane32_swap(__float_as_uint(m), __float_as_uint(m), false, false); return __uint_as_float(rr[0]) + __uint_as_float(rr[1]); }
DI int crow(int r, int hi) { return (r & 3) + 8 * (r >> 2) + 4 * hi; }
#define LDS_WAIT() asm volatile("s_waitcnt lgkmcnt(0)" ::: "memory")
#define VM_WAIT() asm volatile("s_waitcnt vmcnt(0)" ::: "memory")

struct Ctx {
    LAS unsigned char* lds;
    int tid, lane, wave, G, vcu, gw, NGW, bx;
    int rbase, rcnt, lw, NLW;
    unsigned char* ws;
};

#define XB_TMO      128
#define XB_XCNT(j)  (256  + 64 * (j))
#define XB_XSUB(j)  (1280 + 64 * (j))
#define XB_XGEN(j)  (2304 + 64 * (j))
#define XB_TOP      3328
#define XB_TOPGEN   3392
#define XCD_BAR_WORDS 3456
#define XB_SPIN_CAP (1u << 22)
DI unsigned xb_ld(unsigned* p) { return __hip_atomic_load(p, __ATOMIC_RELAXED, __HIP_MEMORY_SCOPE_AGENT); }
DI unsigned xb_add(unsigned* p, unsigned v) { return __hip_atomic_fetch_add(p, v, __ATOMIC_RELAXED, __HIP_MEMORY_SCOPE_AGENT); }
DI unsigned xb_xcc_id() { return (unsigned)__builtin_amdgcn_s_getreg((3 << 11) | 20) & 0xFu; }
#define XB_SPIN(cond, bar) do { unsigned _sp = 0; while (cond) { \
    if ((++_sp & 255u) == 0u) { if (xb_ld(&(bar)[XB_TMO])) break; if (_sp > XB_SPIN_CAP) { atomicAdd(&(bar)[XB_TMO], 1u); break; } } } } while (0)
struct XcdBarrier { unsigned* bar; unsigned x; volatile LAS unsigned* st; };
DI XcdBarrier xcd_barrier_post(unsigned* bar, volatile LAS unsigned* st, int tid) {
    XcdBarrier b; b.bar = bar; b.x = xb_xcc_id(); b.st = st;
    if (tid == 0) (void)xb_add(&bar[XB_XCNT(b.x)], 1u);
    return b;
}
DI void xcd_barrier_complete(unsigned* bar, unsigned x, unsigned& nloc, unsigned& nx) {
    const unsigned G = gridDim.x * gridDim.y * gridDim.z;
    unsigned sum, cnt, mine, sp = 0u;
    for (;;) {
        sum = 0u; cnt = 0u; mine = 0u;
#pragma unroll
        for (unsigned j = 0; j < 16; ++j) { const unsigned c = xb_ld(&bar[XB_XCNT(j)]); sum += c; cnt += (c > 0u) ? 1u : 0u; mine = (j == x) ? c : mine; }
        if (sum == G) break;
        __builtin_amdgcn_s_sleep(1);
        if ((++sp & 255u) == 0u) { if (xb_ld(&bar[XB_TMO])) break; if (sp > XB_SPIN_CAP) { atomicAdd(&bar[XB_TMO], 1u); break; } }
    }
    nloc = mine > 0u ? mine : 1u; nx = cnt > 0u ? cnt : 1u;
}
DI void xcd_barrier(const XcdBarrier& b, int tid, const bool local_seam = false) {
    asm volatile("s_waitcnt vmcnt(0)" ::: "memory");
    __syncthreads();
    if (tid == 0) {
        unsigned* bar = b.bar;
        __builtin_amdgcn_s_waitcnt(0);
        unsigned nloc = b.st[0], nx = b.st[1];
        if (nloc == 0u) { xcd_barrier_complete(bar, b.x, nloc, nx); b.st[0] = nloc; b.st[1] = nx; }
        const bool loc = local_seam && b.st[2] != 0u;
        if (loc) __builtin_amdgcn_fence(__ATOMIC_ACQUIRE, "agent");
        const unsigned old = xb_add(&bar[XB_XSUB(b.x)], 1u);
        const unsigned gen = old / nloc;
        if (loc) {
            if (old + 1u == (gen + 1u) * nloc) xb_add(&bar[XB_XGEN(b.x)], 1u);
            else XB_SPIN(xb_ld(&bar[XB_XGEN(b.x)]) == gen, bar);
            asm volatile("s_waitcnt vmcnt(0)" ::: "memory");
        } else if (old + 1u == (gen + 1u) * nloc) {
            __builtin_amdgcn_fence(__ATOMIC_RELEASE, "agent");
            asm volatile("s_waitcnt vmcnt(0)" ::: "memory");
            const unsigned og = xb_add(&bar[XB_TOP], 1u);
            const unsigned tg = og / nx;
            if (og + 1u == (tg + 1u) * nx) xb_add(&bar[XB_TOPGEN], 1u);
            else XB_SPIN(xb_ld(&bar[XB_TOPGEN]) == tg, bar);
            __builtin_amdgcn_fence(__ATOMIC_ACQUIRE, "agent");
            xb_add(&bar[XB_XGEN(b.x)], 1u);
            asm volatile("s_waitcnt vmcnt(0)" ::: "memory");
        } else {
            XB_SPIN(xb_ld(&bar[XB_XGEN(b.x)]) == gen, bar);
            __builtin_amdgcn_fence(__ATOMIC_ACQUIRE, "agent");
            asm volatile("s_waitcnt vmcnt(0)" ::: "memory");
        }
    }
    __syncthreads();
}

namespace pg8 {
constexpr int BM = 256, BK = 64, HALF = 128, HTB = HALF * BK * 2, NXCD = 8, WGM = 8;
DI int lds_byte(int r, int c) { const int st = (r >> 4) * 2 + (c >> 5), rr = r & 15, cc = c & 31, ob = rr * 64 + cc * 2; return st * 1024 + (ob ^ (((ob >> 9) & 1) << 5)); }
DI void stage_rc(int b, int& R, int& C) { const int st = b / 1024, sb = b % 1024, swz = sb ^ (((sb >> 9) & 1) << 5); R = (st >> 1) * 16 + swz / 64; C = (st & 1) * 32 + (swz % 64) / 2; }
DI int f8_swz(int r) { return ((r >> 1) & 7) ^ ((((r >> 2) ^ (r >> 3)) & 1) << 1); }
DI int lds_byte_f8(int r, int chunk) { return r * 128 + ((chunk ^ f8_swz(r & 15)) << 4); }
DI void stage_rc_f8(int b, int& R, int& C) { R = b >> 7; C = (((b >> 4) & 7) ^ f8_swz(R & 15)) << 3; }
DI int perm32(int rho) { const int n = rho >> 4, i = rho & 15; return 8 * (i >> 2) + 4 * n + (i & 3); }
struct Unit { int pm, pn, half; };
DI bool order_next(int i, int G, int c, int nM, int nN, Unit& u, const int WGM = 8, const bool split = false) {
    const int nwg = nM * nN; long L = (long)i * G + c; u.half = 0;
    if (split && G == 256) { const int F = nwg >> 8, R = nwg & 255;
        if (i == F && R > 0 && R <= 128) { const int t = (c & 7) + 8 * (c >> 4); if (t >= R) return false; L = (long)F * 256 + t; u.half = 1 + ((c >> 3) & 1); } }
    if (L >= nwg) return false;
    int wgid = (int)L; { const int q = nwg / NXCD, r = nwg % NXCD, xcd = wgid % NXCD, off = wgid / NXCD; wgid = (xcd < r ? xcd * (q + 1) : r * (q + 1) + (xcd - r) * q) + off; }
    const int nig = WGM * nN, gid = wgid / nig, fm = gid * WGM, gsz = (nM - fm) < WGM ? (nM - fm) : WGM;
    u.pm = fm + ((wgid % nig) % gsz); u.pn = (wgid % nig) / gsz; return true;
}
DI void moe_chunk(int nM, int x, int& start, int& ntx) { const int base = nM >> 3, rem = nM & 7; ntx = base + (x < rem ? 1 : 0); start = x * base + (x < rem ? x : rem); }
DI bool order_moe(int i, int c, int nM, int nN, Unit& u, const int WGM, const bool split) {
    const int x = c & 7, r = c >> 3; int start, ntx; moe_chunk(nM, x, start, ntx);
    const int nwg = ntx * nN; int L = i * 32 + r; u.half = 0;
    if (split) { const int F = nwg >> 5, R = nwg & 31;
        if (i == F && R > 0 && R <= 16) { const int t = r >> 1; if (t >= R) return false; L = F * 32 + t; u.half = 1 + (r & 1); } }
    if (L >= nwg) return false;
    const int nig = WGM * nN, gid = L / nig, fm = gid * WGM, gsz = (ntx - fm) < WGM ? (ntx - fm) : WGM;
    u.pm = start + fm + ((L % nig) % gsz); u.pn = (L % nig) / gsz; return true;
}
DI void moe_idle(int nM, int nN, int x, int& rx, int& nid_x, int& before, int& total) {
    before = 0; total = 0; rx = 0; nid_x = 0;
#pragma unroll
    for (int y = 0; y < 8; ++y) { int st, nty; moe_chunk(nM, y, st, nty); const int ry = (nty * nN) & 31, ny = ry ? 32 - ry : 0; if (y < x) before += ny; if (y == x) { rx = ry; nid_x = ny; } total += ny; }
}
typedef int v8i32 __attribute__((ext_vector_type(8)));
template <bool F8, bool GATHER, class Epi, class Sched>
DI void gemm_phase(LAS unsigned char* lds, const int tid, const int K, const Sched& S, const Epi& E) {
    const int wid = __builtin_amdgcn_readfirstlane(tid >> 6), lane = tid & 63, wr = wid >> 2, wc = wid & 3, fr = lane & 15, fq = lane >> 4;
    int nt = K / BK; asm volatile("" : "+s"(nt));
    unsigned voffA[2], voffB[2]; int rowA[2];
#pragma unroll
    for (int i = 0; i < 2; ++i) { int R, C; if constexpr (F8) stage_rc_f8(tid * 16 + i * 8192, R, C); else stage_rc(tid * 16 + i * 8192, R, C); const int Rb = Epi::PERM ? ((R & ~31) + perm32(R & 31)) : R;
        voffA[i] = GATHER ? (unsigned)C * 2u : (unsigned)(R * K + C) * 2u; voffB[i] = (unsigned)(Rb * K + C) * 2u; rowA[i] = R; }
    unsigned va[2][2], vn[2][2];
#define PG8_ROWS(dst, ui_) do { if constexpr (GATHER) { const LAS int* rt_ = S.rowtab(ui_); _Pragma("unroll") for (int h_ = 0; h_ < 2; ++h_) _Pragma("unroll") for (int i_ = 0; i_ < 2; ++i_) dst[h_][i_] = (unsigned)rt_[h_ * 128 + rowA[i_]] + voffA[i_]; } } while (0)
#define PG8_STAGE_A(bufoff, abase, h, NEXT) do { if constexpr (GATHER) { const unsigned vo_[2] = {(NEXT) ? vn[h][0] : va[h][0], (NEXT) ? vn[h][1] : va[h][1]}; PG8_STAGE(bufoff, abase, vo_); } \
        else { PG8_STAGE(bufoff, (abase) + (h) * hstep, voffA); } } while (0)
    const size_t kstep = (size_t)(BK * 2);
    const size_t hstep = (size_t)HALF * K * 2;
    const unsigned ldsw = (unsigned)wid * 1024u;
    const int aoff = F8 ? lds_byte_f8(wr * 64 + fr, 2 * fq) : lds_byte(wr * 64 + fr, fq * 8), boff = F8 ? lds_byte_f8(wc * 32 + fr, 2 * fq) : lds_byte(wc * 32 + fr, fq * 8);
    const int aoffx = F8 ? (aoff ^ 16) : aoff + 1024, boffx = F8 ? (boff ^ 16) : boff + 1024;
#define PG8_SA(b, h) (((b) * 2 + (h)) * HTB)
#define PG8_SB(b, h) ((4 + (b) * 2 + (h)) * HTB)
#define PG8_STAGE(bufoff, gbase, voff) do { _Pragma("unroll") for (int _i = 0; _i < 2; ++_i) \
        __builtin_amdgcn_global_load_lds((const unsigned*)((const char*)(gbase) + (voff)[_i]), (LAS unsigned*)(lds + (bufoff) + ldsw + _i * 8192), 16, 0, 0); } while (0)
#define PG8_LDA(dst, b, h) do { _Pragma("unroll") for (int m = 0; m < 4; ++m) _Pragma("unroll") for (int k = 0; k < 2; ++k) dst[m][k] = *(const LAS bf16x8*)(lds + PG8_SA(b, h) + (k ? aoffx : aoff) + m * 2048); } while (0)
#define PG8_LDB(dst, b, h) do { _Pragma("unroll") for (int n = 0; n < 2; ++n) _Pragma("unroll") for (int k = 0; k < 2; ++k) dst[n][k] = *(const LAS bf16x8*)(lds + PG8_SB(b, h) + (k ? boffx : boff) + n * 2048); } while (0)
#define PG8_J8(X) __builtin_bit_cast(v8i32, __builtin_shufflevector((X)[0], (X)[1], 0, 1, 2, 3, 4, 5, 6, 7, 8, 9, 10, 11, 12, 13, 14, 15))
#define PG8_MMA(ai, bj, At, Bt) do { __builtin_amdgcn_s_setprio(1); _Pragma("unroll") for (int m = 0; m < 4; ++m) _Pragma("unroll") for (int n = 0; n < 2; ++n) { \
        if constexpr (F8) { asm volatile("v_mfma_scale_f32_16x16x128_f8f6f4 %0, %1, %2, %0, %3, %3 op_sel_hi:[0,0,0]" : "+v"(acc[ai][bj][m][n]) : "v"(PG8_J8(Bt[n])), "v"(PG8_J8(At[m])), "v"(0x7f7f7f7f)); } \
        else { _Pragma("unroll") for (int k = 0; k < 2; ++k) acc[ai][bj][m][n] = __builtin_amdgcn_mfma_f32_16x16x32_bf16(Bt[n][k], At[m][k], acc[ai][bj][m][n], 0, 0, 0); } } \
        __builtin_amdgcn_s_setprio(0); } while (0)
#define PG8_WAIT_V(n) asm volatile("s_waitcnt vmcnt(" #n ")" ::: "memory")
#define PG8_WAIT_L(n) asm volatile("s_waitcnt lgkmcnt(" #n ")" ::: "memory")
#define PG8_BAR __builtin_amdgcn_s_barrier()
#define PG8_SCHED __builtin_amdgcn_sched_barrier(0)
    Unit cur, nxt; int ui = 0;
    if (!S.next(0, cur)) return;
    f32x4 acc[2][2][4][2];
#pragma unroll
    for (int a = 0; a < 2; ++a)
#pragma unroll
        for (int b = 0; b < 2; ++b)
#pragma unroll
            for (int m = 0; m < 4; ++m)
#pragma unroll
                for (int n = 0; n < 2; ++n) acc[a][b][m][n] = (f32x4){0.f, 0.f, 0.f, 0.f};
    bf16x8 At[4][2], B0[2][2], B1[2][2];
    typename Epi::Pre pre;
    const char* cA = S.aptr(cur); const char* cB = S.bptr(cur);
    PG8_ROWS(va, 0);
    PG8_STAGE(PG8_SB(0, 0), cB, voffB); PG8_STAGE(PG8_SB(0, 1), cB + hstep, voffB); PG8_STAGE_A(PG8_SA(0, 0), cA, 0, false); PG8_STAGE_A(PG8_SA(0, 1), cA, 1, false);
    if (wr == 1) PG8_BAR;
    PG8_WAIT_V(2); PG8_BAR;
    PG8_STAGE(PG8_SB(1, 0), cB + kstep, voffB); PG8_STAGE_A(PG8_SA(1, 0), cA + kstep, 0, false); PG8_STAGE(PG8_SB(1, 1), cB + hstep + kstep, voffB);
    PG8_WAIT_V(6); PG8_BAR;
    for (;;) {
        const bool has_next = S.next(ui + 1, nxt);
        const char* nA = has_next ? S.aptr(nxt) : cA; const char* nB = has_next ? S.bptr(nxt) : cB;
        const bool do0 = cur.half != 2, do1 = cur.half != 1;
        if constexpr (GATHER) { if (has_next) PG8_ROWS(vn, ui + 1); else { _Pragma("unroll") for (int h_ = 0; h_ < 2; ++h_) _Pragma("unroll") for (int i_ = 0; i_ < 2; ++i_) vn[h_][i_] = va[h_][i_]; } }
#pragma clang loop unroll(disable)
        for (int t = 0; t < nt; t += 2) {
            const bool last = (t == nt - 2);
            if constexpr (Epi::EARLY == 1) { if (last) E.prefetch(cur, wr, wc, pre); } else if constexpr (Epi::EARLY == 2) { if (last) E.prefetch_dma(cur, wc, lds + 8 * HTB + wid * 256); }
            const char* a1 = cA + (size_t)(t + 1) * kstep;
            const char* a2 = last ? nA : cA + (size_t)(t + 2) * kstep; const char* b2 = last ? nB : cB + (size_t)(t + 2) * kstep;
            const char* a3 = a2 + kstep; const char* b3 = b2 + kstep;
            PG8_LDB(B0, 0, 0); PG8_LDB(B1, 0, 1); PG8_SCHED; if (do0) PG8_LDA(At, 0, 0); PG8_STAGE_A(PG8_SA(1, 1), a1, 1, false);
            PG8_WAIT_V(8); PG8_WAIT_L(0); PG8_BAR; if (do0) { PG8_MMA(0, 0, At, B0); PG8_MMA(0, 1, At, B1); } PG8_BAR; PG8_SCHED;
            if (do1) PG8_LDA(At, 0, 1); PG8_STAGE(PG8_SB(0, 0), b2, voffB); PG8_STAGE(PG8_SB(0, 1), b2 + hstep, voffB); PG8_STAGE_A(PG8_SA(0, 0), a2, 0, last);
            PG8_WAIT_V(8); PG8_WAIT_L(0); PG8_BAR; if (do1) { PG8_MMA(1, 0, At, B0); PG8_MMA(1, 1, At, B1); } PG8_BAR; PG8_SCHED;
            PG8_LDB(B0, 1, 0); PG8_LDB(B1, 1, 1); PG8_SCHED; if (do0) PG8_LDA(At, 1, 0); PG8_STAGE_A(PG8_SA(0, 1), a2, 1, last);
            PG8_WAIT_V(8); PG8_WAIT_L(0); PG8_BAR; if (do0) { PG8_MMA(0, 0, At, B0); PG8_MMA(0, 1, At, B1); } PG8_BAR; PG8_SCHED;
            if (do1) PG8_LDA(At, 1, 1); PG8_STAGE(PG8_SB(1, 0), b3, voffB); PG8_STAGE(PG8_SB(1, 1), b3 + hstep, voffB); PG8_STAGE_A(PG8_SA(1, 0), a3, 0, last);
            PG8_WAIT_V(8); PG8_WAIT_L(0); PG8_BAR; if (do1) { PG8_MMA(1, 0, At, B0); PG8_MMA(1, 1, At, B1); } PG8_BAR; PG8_SCHED;
        }
        if (wr == 0) PG8_BAR;
        if constexpr (F8) asm volatile("s_nop 15\n\ts_nop 15" ::: "memory");
        if constexpr (Epi::EARLY == 0) E.prefetch(cur, wr, wc, pre); else if constexpr (Epi::EARLY == 2) E.load_pre(lds + 8 * HTB + wid * 256, pre);
        E(acc, cur, wr, wc, fr, fq, pre);
        if (!has_next) break;
#pragma unroll
        for (int a = 0; a < 2; ++a)
#pragma unroll
            for (int b = 0; b < 2; ++b)
#pragma unroll
                for (int m = 0; m < 4; ++m)
#pragma unroll
                    for (int n = 0; n < 2; ++n) acc[a][b][m][n] = (f32x4){0.f, 0.f, 0.f, 0.f};
        cur = nxt; cA = nA; cB = nB; ++ui;
        if constexpr (GATHER) { _Pragma("unroll") for (int h_ = 0; h_ < 2; ++h_) _Pragma("unroll") for (int i_ = 0; i_ < 2; ++i_) va[h_][i_] = vn[h_][i_]; }
        if (wr == 1) PG8_BAR;
    }
    PG8_WAIT_V(0);
    PG8_BAR;
#undef PG8_SA
#undef PG8_SB
#undef PG8_STAGE
#undef PG8_STAGE_A
#undef PG8_ROWS
#undef PG8_LDA
#undef PG8_LDB
#undef PG8_MMA
#undef PG8_J8
#undef PG8_WAIT_V
#undef PG8_WAIT_L
#undef PG8_BAR
#undef PG8_SCHED
}
}
using pg8::Unit;

struct SchedDense {
    const char* A; const char* B; int nM, nN, G, c; size_t tstep; bool split = false;
    DI bool next(int i, Unit& u) const { return pg8::order_next(i, G, c, nM, nN, u, 8, split); }
    DI const char* aptr(const Unit& u) const { return A + (size_t)u.pm * tstep; }
    DI const char* bptr(const Unit& u) const { return B + (size_t)u.pn * tstep; }
    DI const LAS int* rowtab(int) const { return nullptr; }
};
struct SchedUp {
    const char *A, *B; int G, c;
    DI bool next(int i, Unit& u) const { return pg8::order_next(i, G, c, NTOK / 256, 7, u); }
    DI const char* aptr(const Unit& u) const { return A + (size_t)(u.pn >= 3 ? 1 : 0) * (WS_CKVN - WS_CQN) + (size_t)u.pm * (256 * 256); }
    DI const char* bptr(const Unit& u) const { return B + (size_t)u.pn * (256 * 256); }
    DI const LAS int* rowtab(int) const { return nullptr; }
};
#ifndef MOE_WGM
#define MOE_WGM 4
#endif
struct SchedMoe {
    const char* A; const char* B; const LAS int* tile_e; int nM, nN, G, c; bool split = false;
    DI bool next(int i, Unit& u) const { return G == 256 ? pg8::order_moe(i, c, nM, nN, u, MOE_WGM, split) : pg8::order_next(i, G, c, nM, nN, u, MOE_WGM, split); }
    DI const char* aptr(const Unit& u) const { return A + (size_t)u.pm * (256 * 1024); }
    DI const char* bptr(const Unit& u) const { return B + ((size_t)__builtin_amdgcn_readfirstlane(tile_e[u.pm]) * nN + u.pn) * (256 * 1024); }
    DI const LAS int* rowtab(int) const { return nullptr; }
};
struct SchedMoeG {
    const char* A; const char* B; const LAS int* tile_e; const LAS int* rowtab_; int nM, nN, G, c; bool split = false;
    DI bool next(int i, Unit& u) const { return G == 256 ? pg8::order_moe(i, c, nM, nN, u, MOE_WGM, split) : pg8::order_next(i, G, c, nM, nN, u, MOE_WGM, split); }
    DI const char* aptr(const Unit&) const { return A; }
    DI const char* bptr(const Unit& u) const { return B + ((size_t)__builtin_amdgcn_readfirstlane(tile_e[u.pm]) * nN + u.pn) * (256 * 1024); }
    DI const LAS int* rowtab(int ui) const { return rowtab_ + ui * 256; }
};

#define EPI_LANE0() int z0_ = 0; asm volatile("" : "+v"(z0_)); const int ln0_ = (int)__builtin_amdgcn_mbcnt_hi(~0u, __builtin_amdgcn_mbcnt_lo(~0u, (unsigned)z0_)); const int fq = ln0_ >> 4
#define EPI_LANE() int z_ = 0; asm volatile("" : "+v"(z_)); const int ln_ = (int)__builtin_amdgcn_mbcnt_hi(~0u, __builtin_amdgcn_mbcnt_lo(~0u, (unsigned)z_)); const int fr = ln_ & 15, fq = ln_ >> 4; (void)fr_; (void)fq_
struct PreNone { };
struct Pre4 { f32x4 v[2][2]; };
struct EpiProj {
    static constexpr int EARLY = 0; static constexpr bool PERM = true; bf16_t* O; int ldc; float sc; typedef PreNone Pre;
    DI void prefetch(const Unit&, int, int, Pre&) const {}
    DI void operator()(const f32x4 (&acc)[2][2][4][2], const Unit& u, int wr, int wc, int fr_, int fq_, const Pre&) const {
        EPI_LANE();
        const int row0 = u.pm * 256 + wr * 64 + fr, col0 = u.pn * 256 + wc * 32 + 8 * fq;
#pragma unroll
        for (int ai = 0; ai < 2; ++ai)
#pragma unroll
            for (int m = 0; m < 4; ++m) { if (u.half != 0 && ai != u.half - 1) continue;     bf16_t* rowp = O + (size_t)(row0 + ai * 128 + m * 16) * ldc + col0;
#pragma unroll
                for (int bj = 0; bj < 2; ++bj) { const f32x4 v0 = acc[ai][bj][m][0] * sc, v1 = acc[ai][bj][m][1] * sc;
                    u32x4 w; w.x = cvtpk(v0[0], v0[1]); w.y = cvtpk(v0[2], v0[3]); w.z = cvtpk(v1[0], v1[1]); w.w = cvtpk(v1[2], v1[3]);
                    *(u32x4*)(rowp + bj * 128) = w; } }
    }
};
template <bool SRC_F32>
struct EpiOut {
    static constexpr int EARLY = 0; static constexpr bool PERM = false; bf16_t* XR; const float* xsrc; const float* gm; float sc; typedef Pre4 Pre;
    DI void prefetch(const Unit& u, int wr, int wc, Pre& pre) const { EPI_LANE0(); const int col0 = u.pn * 256 + wc * 32 + 4 * fq; const int b = u.pm >> 3;
#pragma unroll
        for (int bj = 0; bj < 2; ++bj)
#pragma unroll
            for (int n = 0; n < 2; ++n) pre.v[bj][n] = *(const f32x4*)(gm + b * 6144 + col0 + bj * 128 + n * 16) * sc; }
    DI void operator()(const f32x4 (&acc)[2][2][4][2], const Unit& u, int wr, int wc, int fr_, int fq_, const Pre& pre) const {
        EPI_LANE();
        const int row0 = u.pm * 256 + wr * 64 + fr, col0 = u.pn * 256 + wc * 32 + 4 * fq;
        const f32x4 (&g)[2][2] = pre.v;
#pragma unroll
        for (int ai = 0; ai < 2; ++ai)
#pragma unroll
            for (int m = 0; m < 4; ++m) { const size_t ro = (size_t)(row0 + ai * 128 + m * 16) * DM + col0;
#pragma unroll
                for (int bj = 0; bj < 2; ++bj)
#pragma unroll
                    for (int n = 0; n < 2; ++n) { const size_t o = ro + bj * 128 + n * 16; f32x4 r;
                        if constexpr (SRC_F32) r = *(const f32x4*)(xsrc + o); else { const u32x2 w = *(const u32x2*)(XR + o); r = (f32x4){bflo(w.x), bfhi(w.x), bflo(w.y), bfhi(w.y)}; }
                        r = r + g[bj][n] * acc[ai][bj][m][n];
                        u32x2 ow; ow.x = cvtpk(r[0], r[1]); ow.y = cvtpk(r[2], r[3]); *(u32x2*)(XR + o) = ow; } }
    }
};
struct EpiSwiglu {
    static constexpr int EARLY = 2; static constexpr bool PERM = true; unsigned char* O; const float* b1; const LAS int* tile_e; typedef Pre4 Pre;
    DI void prefetch(const Unit& u, int wr, int wc, Pre& pre) const { EPI_LANE0(); const int e = __builtin_amdgcn_readfirstlane(tile_e[u.pm]); const float* bb = b1 + e * 2048 + u.pn * 128 + wc * 32 + 8 * fq;
        pre.v[0][0] = *(const f32x4*)(bb); pre.v[0][1] = *(const f32x4*)(bb + 4); pre.v[1][0] = *(const f32x4*)(bb + 1024); pre.v[1][1] = *(const f32x4*)(bb + 1028); }
    DI void prefetch_dma(const Unit& u, int wc, LAS unsigned char* slot) const { int z0_ = 0; asm volatile("" : "+v"(z0_)); const int ln0_ = (int)__builtin_amdgcn_mbcnt_hi(~0u, __builtin_amdgcn_mbcnt_lo(~0u, (unsigned)z0_));
        const int e = __builtin_amdgcn_readfirstlane(tile_e[u.pm]); const float* src = b1 + e * 2048 + u.pn * 128 + wc * 32 + (ln0_ & 31) + (ln0_ >> 5) * 1024;
        __builtin_amdgcn_global_load_lds((const unsigned*)src, (LAS unsigned*)slot, 4, 0, 0); }
    DI void load_pre(const LAS unsigned char* slot, Pre& pre) const { EPI_LANE0(); const LAS float* sl_ = (const LAS float*)slot + 8 * fq;
        pre.v[0][0] = *(const LAS f32x4*)(sl_); pre.v[0][1] = *(const LAS f32x4*)(sl_ + 4); pre.v[1][0] = *(const LAS f32x4*)(sl_ + 32); pre.v[1][1] = *(const LAS f32x4*)(sl_ + 36); }
    DI void operator()(const f32x4 (&acc)[2][2][4][2], const Unit& u, int wr, int wc, int fr_, int fq_, const Pre& pre) const {
        EPI_LANE();
        const int row0 = u.pm * 256 + wr * 64 + fr, col0 = u.pn * 128 + wc * 32 + 8 * fq;
        constexpr float sc = 1.0f / (X_SCALE * W_SCALE);
        const f32x4 bg0 = pre.v[0][0], bg1 = pre.v[0][1], bl0 = pre.v[1][0], bl1 = pre.v[1][1];
#pragma unroll
        for (int ai = 0; ai < 2; ++ai)
#pragma unroll
            for (int m = 0; m < 4; ++m) { if (u.half != 0 && ai != u.half - 1) continue;
                float r[8];
#pragma unroll
                for (int q = 0; q < 4; ++q) { const f32x4 ag = acc[ai][0][m][q >> 1], al = acc[ai][1][m][q >> 1]; const f32x4 bg = (q >> 1) ? bg1 : bg0, bl = (q >> 1) ? bl1 : bl0; const int o = 2 * (q & 1);
                    f32x2 g = (f32x2){ag[o], ag[o + 1]} * sc + (f32x2){bg[o], bg[o + 1]}; f32x2 l = (f32x2){al[o], al[o + 1]} * sc + (f32x2){bl[o], bl[o + 1]};
                    g.x = fminf(g.x, 7.0f); g.y = fminf(g.y, 7.0f); l.x = __builtin_amdgcn_fmed3f(l.x, -7.0f, 7.0f); l.y = __builtin_amdgcn_fmed3f(l.y, -7.0f, 7.0f);
                    f32x2 t = g * (-1.702f * LOG2E); t.x = __builtin_amdgcn_exp2f(t.x); t.y = __builtin_amdgcn_exp2f(t.y);
                    f32x2 d = t + 1.0f; d.x = __builtin_amdgcn_rcpf(d.x); d.y = __builtin_amdgcn_rcpf(d.y);
                    const f32x2 lh = l * H_SCALE + H_SCALE; const f32x2 y = (g * d) * lh;
                    r[2 * q] = y.x; r[2 * q + 1] = y.y; }
                u32x2 w; w.x = pk4_fp8_nc(r[0], r[1], r[2], r[3]); w.y = pk4_fp8_nc(r[4], r[5], r[6], r[7]);
                *(u32x2*)(O + (size_t)(row0 + ai * 128 + m * 16) * DEXP + col0) = w; }
    }
};
struct EpiDown {
    static constexpr int EARLY = 1; static constexpr bool PERM = true; unsigned char* O; const float* b2; const LAS int* tile_e; typedef Pre4 Pre;
    DI void prefetch(const Unit& u, int wr, int wc, Pre& pre) const { EPI_LANE0(); const int e = __builtin_amdgcn_readfirstlane(tile_e[u.pm]); const int col0 = u.pn * 256 + wc * 32 + 8 * fq;
#pragma unroll
        for (int bj = 0; bj < 2; ++bj)
#pragma unroll
            for (int n = 0; n < 2; ++n) pre.v[bj][n] = *(const f32x4*)(b2 + e * 1024 + col0 + bj * 128 + 4 * n); }
    DI void operator()(const f32x4 (&acc)[2][2][4][2], const Unit& u, int wr, int wc, int fr_, int fq_, const Pre& pre) const {
        EPI_LANE();
        const int row0 = u.pm * 256 + wr * 64 + fr, col0 = u.pn * 256 + wc * 32 + 8 * fq;
        const f32x4 (&bv)[2][2] = pre.v;
#pragma unroll
        for (int ai = 0; ai < 2; ++ai)
#pragma unroll
            for (int m = 0; m < 4; ++m) { if (u.half != 0 && ai != u.half - 1) continue;     unsigned char* rowp = O + (size_t)(row0 + ai * 128 + m * 16) * DM + col0;
#pragma unroll
                for (int bj = 0; bj < 2; ++bj) { constexpr float sc = YE_SCALE / (H_SCALE * W_SCALE); const f32x4 v0 = acc[ai][bj][m][0] * sc + bv[bj][0] * YE_SCALE, v1 = acc[ai][bj][m][1] * sc + bv[bj][1] * YE_SCALE;
                    u32x2 w; w.x = pk4_fp8(v0[0], v0[1], v0[2], v0[3]); w.y = pk4_fp8(v1[0], v1[1], v1[2], v1[3]);
                    *(u32x2*)(rowp + bj * 128) = w; } }
    }
};

template <class RM>
DI void transpose_item(const float* W, int K, int N, bf16_t* WT, int ldt, LAS float* scr, int kb, int nb, int lane, RM rm) {
    const int k0 = 64 * kb, n0 = 32 * nb; const int nn = n0 + (lane & 31); const bool ok = nn < N;
#pragma unroll 8
    for (int i = 0; i < 32; ++i) { const int kk = 2 * i + (lane >> 5); scr[kk * 33 + (lane & 31)] = ok ? W[(size_t)(k0 + kk) * N + nn] : 0.f; }
    LDS_WAIT(); asm volatile("" ::: "memory");
    const int c = lane & 7;
#pragma unroll
    for (int j = 0; j < 4; ++j) { const int nl = (lane >> 3) + 8 * j; const int n = n0 + nl; const LAS float* s = scr + (8 * c) * 33 + nl;
        u32x4 o; o.x = cvtpk(s[0 * 33], s[1 * 33]); o.y = cvtpk(s[2 * 33], s[3 * 33]); o.z = cvtpk(s[4 * 33], s[5 * 33]); o.w = cvtpk(s[6 * 33], s[7 * 33]);
        if (n < N) *(u32x4*)(WT + (size_t)rm(n) * ldt + k0 + 8 * c) = o; }
    LDS_WAIT(); asm volatile("" ::: "memory");
}
template <class RM>
DI void transpose_item_f8(const float* W, int K, int N, unsigned char* WT, int ldt, LAS float* scr, int kb, int nb, int lane, RM rm, float sc) {
    const int k0 = 64 * kb, n0 = 32 * nb; const int nl = lane & 31, kh = lane >> 5;
#pragma unroll 8
    for (int i = 0; i < 32; ++i) { const int kk = 2 * i + kh; scr[kk * 33 + nl] = W[(size_t)(k0 + kk) * N + n0 + nl]; }
    LDS_WAIT(); asm volatile("" ::: "memory");
    const LAS float* s = scr + (32 * kh) * 33 + nl; unsigned w[8];
#pragma unroll
    for (int i = 0; i < 8; ++i) w[i] = pk4_fp8(s[(4 * i) * 33] * sc, s[(4 * i + 1) * 33] * sc, s[(4 * i + 2) * 33] * sc, s[(4 * i + 3) * 33] * sc);
    unsigned char* d = WT + (size_t)rm(n0 + nl) * ldt + k0 + 32 * kh;
    *(u32x4*)d = (u32x4){w[0], w[1], w[2], w[3]}; *(u32x4*)(d + 16) = (u32x4){w[4], w[5], w[6], w[7]};
    LDS_WAIT(); asm volatile("" ::: "memory");
}
struct RmId { DI int operator()(int n) const { return n; } };
struct RmIn { DI int operator()(int n) const { return n < 2112 ? n : (n < 2120 ? PC_WI + (n - 2112) : n - 8); } };
struct RmW1 { DI int operator()(int n) const { const int j = n & 1023; return 256 * (j >> 7) + (n >= 1024 ? 128 : 0) + (j & 127); } };

struct TDesc { const float* src; unsigned char* dst; int N, ldt, k0, n0, kind; };
DI void t_decode(KP p, unsigned char* ws, int it, TDesc& d) {
    constexpr int I_IN = 16 * 80, I_UQ = 4 * 24, I_UKV = 2 * 32, I_OUT = 16 * 32, I_W1 = 16 * 64, I_W2 = 16 * 32;
    constexpr int I_LAYER = I_IN + I_UQ + I_UKV + I_OUT + 32 * (I_W1 + I_W2);
    const int l = it / I_LAYER; int r = it % I_LAYER;
    if (r < I_IN) { d.src = p->w_in + (size_t)l * 1024 * D_IN; d.N = D_IN; d.k0 = 64 * (r / 80); d.n0 = 32 * (r % 80);
        if (d.n0 < PC_QI) { d.dst = ws + WS_WIN8 + (size_t)l * D_INP * 1024; d.ldt = 1024; d.kind = 2; } else { d.dst = ws + WS_WIN8 + (size_t)l * D_INP * 1024; d.ldt = 1024; d.kind = 4; }
        return; } r -= I_IN;
    if (r < I_UQ) { d.src = p->w_uq + (size_t)l * 256 * 768; d.N = 768; d.dst = ws + WS_WUP + (size_t)l * 1792 * 256; d.ldt = 256; d.k0 = 64 * (r / 24); d.n0 = 32 * (r % 24); d.kind = 2; return; } r -= I_UQ;
    if (r < I_UKV) { d.src = p->w_ukv + (size_t)l * 128 * 1024; d.N = 1024; d.dst = ws + WS_WUP + ((size_t)l * 1792 + 768) * 256; d.ldt = 256; d.k0 = 64 * (r / 32); d.n0 = 32 * (r % 32); d.kind = 2; return; } r -= I_UKV;
    if (r < I_OUT) { d.src = p->w_out + (size_t)l * 1024 * 1024; d.N = 1024; d.dst = ws + WS_WOUT + (size_t)l * 1024 * 1024; d.ldt = 1024; d.k0 = 64 * (r / 32); d.n0 = 32 * (r % 32); d.kind = 2; return; } r -= I_OUT;
    if (r < 32 * I_W1) { const int e = r / I_W1, q = r % I_W1; d.src = p->w1 + ((size_t)l * 32 + e) * 1024 * 2048; d.N = 2048; d.dst = ws + WS_W1 + ((size_t)l * 32 + e) * 2048 * 1024; d.ldt = 1024; d.k0 = 64 * (q / 64); d.n0 = 32 * (q % 64); d.kind = 3; return; } r -= 32 * I_W1;
    { const int e = r / I_W2, q = r % I_W2; d.src = p->w2 + ((size_t)l * 32 + e) * 1024 * 1024; d.N = 1024; d.dst = ws + WS_W2 + ((size_t)l * 32 + e) * 1024 * 1024; d.ldt = 1024; d.k0 = 64 * (q / 32); d.n0 = 32 * (q % 32); d.kind = 2; }
}
DI void t_load(const TDesc& d, int lane, f32x4 (&r)[8]) {
    const int kk = lane >> 3, nq = 4 * (lane & 7); const bool ok = d.n0 + nq < d.N;
    const float* s = d.src + (size_t)(d.k0 + kk) * d.N + d.n0 + nq;
#pragma unroll
    for (int i = 0; i < 8; ++i) r[i] = ok ? __builtin_nontemporal_load((const f32x4*)(s + (size_t)(8 * i) * d.N)) : (f32x4){0.f, 0.f, 0.f, 0.f};
}
DI void t_store(const TDesc& d, LAS float* scr, int lane, const f32x4 (&r)[8]) {
    { const int kk = lane >> 3, nq = 4 * (lane & 7);
#pragma unroll
      for (int i = 0; i < 8; ++i)
#pragma unroll
          for (int e = 0; e < 4; ++e) scr[(8 * i + kk) * 33 + nq + e] = r[i][e]; }
    LDS_WAIT(); asm volatile("" ::: "memory");
    if (d.kind < 2) {
        const int cc = lane & 7;
#pragma unroll
        for (int j = 0; j < 4; ++j) { const int nl = (lane >> 3) + 8 * j; const int n = d.n0 + nl; const LAS float* s = scr + (8 * cc) * 33 + nl;
            u32x4 o; o.x = cvtpk(s[0 * 33], s[1 * 33]); o.y = cvtpk(s[2 * 33], s[3 * 33]); o.z = cvtpk(s[4 * 33], s[5 * 33]); o.w = cvtpk(s[6 * 33], s[7 * 33]);
            const int row = d.kind == 1 ? (n < 2112 ? n : (n < 2120 ? PC_WI + (n - 2112) : n - 8)) : n;
            if (n < d.N) *(u32x4*)(d.dst + (size_t)row * d.ldt + (d.k0 + 8 * cc) * 2) = o; }
    } else {
        const int nl = lane & 31, kh = lane >> 5; const LAS float* s = scr + (32 * kh) * 33 + nl; unsigned w[8];
#pragma unroll
        for (int i = 0; i < 8; ++i) w[i] = pk4_fp8(s[(4 * i) * 33] * W_SCALE, s[(4 * i + 1) * 33] * W_SCALE, s[(4 * i + 2) * 33] * W_SCALE, s[(4 * i + 3) * 33] * W_SCALE);
        const int n = d.n0 + nl; const int jn = n & 1023;
        int row = n;
        if (d.kind == 3) row = 256 * (jn >> 7) + (n >= 1024 ? 128 : 0) + (jn & 127);
        else if (d.kind == 4) { row = n - 8; if (n < 2120) row = PC_WI + (n - 2112); if (n < 2112) row = n; if (n >= D_IN) row = 2552 + (n & 7); }
        unsigned char* o = d.dst + (size_t)row * d.ldt + d.k0 + 32 * kh;
        *(u32x4*)o = (u32x4){w[0], w[1], w[2], w[3]}; *(u32x4*)(o + 16) = (u32x4){w[4], w[5], w[6], w[7]};
    }
    LDS_WAIT(); asm volatile("" ::: "memory");
}
DI void big_src(KP p, int it, const float*& src, int& N, size_t& dstoff, int& k0, int& n0, int& w1map) {
    constexpr int I_W1 = 8 * 8, I_W2 = 8 * 4, I_L = 32 * (I_W1 + I_W2);
    const int l = it / I_L; int r = it % I_L;
    if (r < 32 * I_W1) { const int e = r / I_W1, q = r % I_W1; src = p->w1 + ((size_t)l * 32 + e) * 1024 * 2048; N = 2048; dstoff = WS_W1 + ((size_t)l * 32 + e) * 2048 * 1024; k0 = 128 * (q / 8); n0 = 256 * (q % 8); w1map = 1; }
    else { r -= 32 * I_W1; const int e = r / I_W2, q = r % I_W2; src = p->w2 + ((size_t)l * 32 + e) * 1024 * 1024; N = 1024; dstoff = WS_W2 + ((size_t)l * 32 + e) * 1024 * 1024; k0 = 128 * (q / 4); n0 = 256 * (q % 4); w1map = 0; }
}
DI void big_load(const float* src, int N, int k0, int n0, int wave, int lane, f32x4 (&r)[16]) {
    const float* s = src + (size_t)(k0 + 16 * wave) * N + n0 + 4 * lane;
#pragma unroll
    for (int i = 0; i < 16; ++i) r[i] = __builtin_nontemporal_load((const f32x4*)(s + (size_t)i * N));
}
constexpr int BIG_TOTAL = DEPTH * 32 * (8 * 8 + 8 * 4), BIG_L1 = 32 * (8 * 8 + 8 * 4), BIG_ND = 1024;
DI void big_convert(KP p, const Ctx& c, int first, int stride, int count, int limit, int thr, int add) {
    constexpr int TP = 260;
    LAS float* tile = (LAS float*)c.lds;
    const float* src; int N, k0, n0, w1m; size_t doff; f32x4 rc[16], rn[16];
    int r = first, j = 0;
    bool have = count > 0 && r < limit;
    if (have) { big_src(p, r + (r >= thr ? add : 0), src, N, doff, k0, n0, w1m); big_load(src, N, k0, n0, c.wave, c.lane, rc); }
    while (have) {
        const int rn_ = r + stride; ++j; const bool hn = j < count && rn_ < limit;
        const float* nsrc = src; int nN = N, nk0 = k0, nn0 = n0, nw1 = w1m; size_t ndoff = doff;
        if (hn) { big_src(p, rn_ + (rn_ >= thr ? add : 0), nsrc, nN, ndoff, nk0, nn0, nw1); big_load(nsrc, nN, nk0, nn0, c.wave, c.lane, rn); }
#pragma unroll
        for (int i = 0; i < 16; ++i) *(LAS f32x4*)(tile + (16 * c.wave + i) * TP + 4 * c.lane) = rc[i];
        __syncthreads();
        { const int nl = c.tid >> 1, kh = c.tid & 1;
          const LAS float* t0 = tile + (64 * kh) * TP + nl; unsigned w[16];
#pragma unroll
          for (int i = 0; i < 16; ++i) w[i] = pk4_fp8(t0[(4 * i) * TP] * W_SCALE, t0[(4 * i + 1) * TP] * W_SCALE, t0[(4 * i + 2) * TP] * W_SCALE, t0[(4 * i + 3) * TP] * W_SCALE);
          const int n = n0 + nl; const int jn = n & 1023; const int row = w1m ? 256 * (jn >> 7) + (n >= 1024 ? 128 : 0) + (jn & 127) : n;
          unsigned char* o = c.ws + doff + (size_t)row * 1024 + k0 + 64 * kh;
#pragma unroll
          for (int q = 0; q < 4; ++q) *(u32x4*)(o + 16 * q) = (u32x4){w[4 * q], w[4 * q + 1], w[4 * q + 2], w[4 * q + 3]}; }
        __syncthreads();
        if (!hn) break;
        src = nsrc; N = nN; k0 = nk0; n0 = nn0; w1m = nw1; doff = ndoff; r = rn_;
#pragma unroll
        for (int i = 0; i < 16; ++i) rc[i] = rn[i];
    }
}
DI void phase_prologue(KP p, const Ctx& c) {
    LAS float* scr = (LAS float*)(c.lds + c.wave * 16384);
    bf16_t* WUP = (bf16_t*)(c.ws + WS_WUP);
    {
        constexpr int I_SMALL = 16 * 80 + 4 * 24 + 2 * 32 + 16 * 32;
        constexpr int I_LAYER = I_SMALL + 32 * (16 * 64 + 16 * 32);
        for (int j = c.gw; j < DEPTH * I_SMALL; j += c.NGW) { const int it = (j / I_SMALL) * I_LAYER + (j % I_SMALL);
            TDesc dc; f32x4 rc[8]; t_decode(p, c.ws, it, dc); t_load(dc, c.lane, rc); t_store(dc, scr, c.lane, rc); }
    }
    __syncthreads();
    big_convert(p, c, c.vcu, c.G, 1 << 20, BIG_TOTAL - BIG_ND, BIG_L1, BIG_ND);
    __syncthreads();
    for (int i = c.gw * 64 + c.lane; i < DEPTH * 1024 * 8; i += c.NGW * 64) { const int l = i >> 13, row = (i >> 3) & 1023, ch = i & 7; *(u32x4*)((unsigned char*)WUP + ((size_t)l * 1792 + 768 + row) * 256 + 128 + ch * 16) = (u32x4){0u, 0u, 0u, 0u}; }
    {
        float* ROPE = (float*)(c.ws + WS_ROPE);
        const float inv = (float)pow(10000.0, -(double)(c.lane & 15) / 16.0);
        for (int i = c.gw * 64 + c.lane; i < NTOK * 16; i += c.NGW * 64) { const int m = i >> 4, j = i & 15;
            const float ang = (float)p->pos[m] * inv;
            const double a = (double)ang; const double n = rint(a * 0.15915494309189535); const double rr = a - n * 6.283185307179586476925;
            const float rf = (float)rr;
            ROPE[m * 32 + j] = cosf(rf); ROPE[m * 32 + 16 + j] = sinf(rf); }
    }
    __syncthreads();
    {
        LAS float* cond = (LAS float*)c.lds;
        LAS float* red = (LAS float*)(c.lds + 32768);
        float* MODS = (float*)(c.ws + WS_MODS);
        bool have = false;
        for (int it = c.vcu; it < DEPTH * 96; it += c.G) {
            if (!have) { for (int i = c.tid; i < 8192; i += 512) { const int b = i >> 10, k = i & 1023; const float v = p->c[b * 1024 + k]; cond[k * 8 + b] = v / (1.0f + __expf(-v)); } have = true; __syncthreads(); }
            const int l = it / 96, j0 = (it % 96) * 64;
            const float* W = p->w_ada + (size_t)l * 1024 * 6144 + j0 + c.lane;
            float a[8] = {0.f, 0.f, 0.f, 0.f, 0.f, 0.f, 0.f, 0.f};
#pragma unroll 32
            for (int kk = 0; kk < 128; ++kk) { const int k = c.wave * 128 + kk; const float w = W[(size_t)k * 6144];
                const f32x4 c0 = *(const LAS f32x4*)(cond + k * 8), c1 = *(const LAS f32x4*)(cond + k * 8 + 4);
                a[0] += c0[0] * w; a[1] += c0[1] * w; a[2] += c0[2] * w; a[3] += c0[3] * w; a[4] += c1[0] * w; a[5] += c1[1] * w; a[6] += c1[2] * w; a[7] += c1[3] * w; }
#pragma unroll
            for (int b = 0; b < 8; ++b) red[(c.wave * 8 + b) * 64 + c.lane] = a[b];
            __syncthreads();
            { const int b = c.tid >> 6, j = c.tid & 63; float s = p->b_ada[l * 6144 + j0 + j];
#pragma unroll
              for (int w = 0; w < 8; ++w) s += red[(w * 8 + b) * 64 + j];
              MODS[(l * 8 + b) * 6144 + j0 + j] = s; }
            __syncthreads();
        }
    }
}

DI int build_tiles(const Ctx& c, int layer) {
    const unsigned* gcnt = (const unsigned*)(c.ws + WS_CTL) + CW_GCNT + layer * 64;
    LAS int* pst = (LAS int*)(c.lds + LC_PST); LAS int* tile_e = (LAS int*)(c.lds + LC_TILEE);
    __syncthreads();
    LAS int* cnt = (LAS int*)(c.lds + LC_CNT);
    if (c.tid < 32) cnt[c.tid] = (int)__hip_atomic_load(&gcnt[c.tid], __ATOMIC_RELAXED, __HIP_MEMORY_SCOPE_AGENT);
    __syncthreads();
    if (c.tid < 64) {
        const int e = c.tid & 31; const int n = (cnt[e] + 255) >> 8; int incl = n;
#pragma unroll
        for (int o = 1; o < 32; o <<= 1) { const int v = __builtin_amdgcn_ds_bpermute(((c.tid - o) & 63) << 2, incl); if (e >= o) incl += v; }
        const int st = incl - n;
        if (c.tid < 32) { pst[e] = st; if (e == 31) pst[32] = incl; for (int i = 0; i < n; ++i) tile_e[st + i] = e; }
    }
    __syncthreads();
    return pst[32];
}
DI int reuse_tiles(const Ctx& c, int layer) {
#if MULTI_LAUNCH
    return build_tiles(c, layer);
#else
    (void)layer; __syncthreads(); return ((const LAS int*)(c.lds + LC_PST))[32];
#endif
}
DI void load_row(const float* src, int lane, f32x4 (&v)[4]) {
#pragma unroll
    for (int j = 0; j < 4; ++j) v[j] = __builtin_nontemporal_load((const f32x4*)(src + 4 * lane + 256 * j));
}
DI void load_row_bf(const bf16_t* src, int lane, f32x4 (&v)[4]) {
#pragma unroll
    for (int j = 0; j < 4; ++j) { const u32x2 w = __builtin_nontemporal_load((const u32x2*)(src + 4 * lane + 256 * j)); v[j] = (f32x4){bflo(w.x), bfhi(w.x), bflo(w.y), bfhi(w.y)}; }
}
template <int RB>
DI void moe_combine(const Ctx& c, int m0, const f32x4 (&gf)[4]  , f32x4 (&v)[RB][4]) {
    const int* ME = (const int*)(c.ws + WS_ME); const int* MR = (const int*)(c.ws + WS_MR); const float* MG = (const float*)(c.ws + WS_MG); const unsigned char* Y = c.ws + WS_YEXP;
    const LAS int* pst = (const LAS int*)(c.lds + LC_PST);
    int me[RB][4], mr[RB][4]; float mg[RB][4];
#pragma unroll
    for (int i = 0; i < RB; ++i)
#pragma unroll
        for (int k = 0; k < 4; ++k) { me[i][k] = ME[(m0 + i) * 4 + k]; mr[i][k] = MR[(m0 + i) * 4 + k]; mg[i][k] = MG[(m0 + i) * 4 + k]; }
    unsigned w[RB][4][4];
#pragma unroll
    for (int i = 0; i < RB; ++i)
#pragma unroll
        for (int k = 0; k < 4; ++k) { const int d = pst[me[i][k]] * 256 + mr[i][k]; const unsigned char* row = Y + (size_t)d * DM + 4 * c.lane;
#pragma unroll
            for (int j = 0; j < 4; ++j) w[i][k][j] = __builtin_nontemporal_load((const unsigned*)(row + 256 * j)); }
#pragma unroll
    for (int i = 0; i < RB; ++i) { f32x4 a[4];
#pragma unroll
        for (int j = 0; j < 4; ++j) a[j] = (f32x4){0.f, 0.f, 0.f, 0.f};
#pragma unroll
        for (int k = 0; k < 4; ++k) { const float g = mg[i][k] * (1.0f / YE_SCALE);
#pragma unroll
            for (int j = 0; j < 4; ++j) { const int ww = (int)w[i][k][j]; const f32x2 lo = __builtin_amdgcn_cvt_pk_f32_fp8(ww, false), hi2 = __builtin_amdgcn_cvt_pk_f32_fp8(ww, true);
                a[j][0] += g * lo[0]; a[j][1] += g * lo[1]; a[j][2] += g * hi2[0]; a[j][3] += g * hi2[1]; } }
#pragma unroll
        for (int j = 0; j < 4; ++j) v[i][j] = v[i][j] + gf[j] * a[j]; }
}
DI float row_rinv(const f32x4 (&v)[4], int lane) {
    float s = 0.f;
#pragma unroll
    for (int j = 0; j < 4; ++j) s += (v[j][0] * v[j][0] + v[j][1] * v[j][1]) + (v[j][2] * v[j][2] + v[j][3] * v[j][3]);
    s = wave_sum(s, lane);
    return 1.0f / sqrtf(s * (1.0f / 1024.0f) + EPS);
}
struct ModVec { f32x4 w[4], s[4]; };
DI void modvec_load(const float* nw, const float* sh, const float* sc, int lane, ModVec& mv) {
#pragma unroll
    for (int j = 0; j < 4; ++j) { const int o = 4 * lane + 256 * j; mv.w[j] = *(const f32x4*)(nw + o) * (*(const f32x4*)(sc + o) + 1.0f); mv.s[j] = *(const f32x4*)(sh + o); }
}
DI void modulate(const f32x4 (&v)[4], float r, const ModVec& mv, f32x4 (&h)[4]) {
#pragma unroll
    for (int j = 0; j < 4; ++j) h[j] = v[j] * r * mv.w[j] + mv.s[j];
}
DI void store_row_bf16(bf16_t* dst, int lane, const f32x4 (&h)[4]) {
#pragma unroll
    for (int j = 0; j < 4; ++j) { u32x2 w; w.x = cvtpk(h[j][0], h[j][1]); w.y = cvtpk(h[j][2], h[j][3]); *(u32x2*)(dst + 4 * lane + 256 * j) = w; }
}

DI void phase_norm_mix(KP p, const Ctx& c, int layer) {
    bf16_t* XR = (bf16_t*)(c.ws + WS_XR); const float* MODS = (const float*)(c.ws + WS_MODS);
    if (layer > 0) (void)reuse_tiles(c, layer - 1);
    constexpr int RB = 2;
    ModVec mv; f32x4 gf[4] = {}; int bcur = -1;
    for (int mm = c.lw * RB; mm < c.rcnt; mm += c.NLW * RB) { const int m0 = c.rbase + mm; const int b = m0 >> 11;
        if (b != bcur) { bcur = b; const float* md = MODS + (layer * 8 + b) * 6144; modvec_load(p->norm_mix + layer * 1024, md, md + 1024, c.lane, mv);
            if (layer > 0) {
#pragma unroll
                for (int j = 0; j < 4; ++j) gf[j] = *(const f32x4*)(MODS + ((layer > 0 ? layer - 1 : 0) * 8 + b) * 6144 + 5 * 1024 + 4 * c.lane + 256 * j); } }
        f32x4 v[RB][4];
#pragma unroll
        for (int i = 0; i < RB; ++i) { if (layer == 0) load_row(p->x + (size_t)(m0 + i) * DM, c.lane, v[i]); else load_row_bf(XR + (size_t)(m0 + i) * DM, c.lane, v[i]); }
        if (layer > 0) moe_combine<RB>(c, m0, gf, v);
#pragma unroll
        for (int i = 0; i < RB; ++i) { const int m = m0 + i; f32x4 h[4];
            if (layer > 0) store_row_bf16(XR + (size_t)m * DM, c.lane, v[i]);
            const float r = row_rinv(v[i], c.lane);
            modulate(v[i], r, mv, h);
#pragma unroll
            for (int j = 0; j < 4; ++j) *(unsigned*)(c.ws + WS_H8IN + (size_t)m * DM + 4 * c.lane + 256 * j) = pk4_fp8(h[j][0] * X_SCALE, h[j][1] * X_SCALE, h[j][2] * X_SCALE, h[j][3] * X_SCALE); }
    }
}
DI void phase_final(KP p, const Ctx& c) {
    const bf16_t* XR = (const bf16_t*)(c.ws + WS_XR); const float* MODS = (const float*)(c.ws + WS_MODS);
    (void)reuse_tiles(c, DEPTH - 1);
    constexpr int RB = 2;
    f32x4 wf[4], gf[4] = {}; int bcur = -1;
#pragma unroll
    for (int j = 0; j < 4; ++j) wf[j] = *(const f32x4*)(p->norm_final + 4 * c.lane + 256 * j);
    for (int mm = c.lw * RB; mm < c.rcnt; mm += c.NLW * RB) { const int m0 = c.rbase + mm; const int b = m0 >> 11;
        if (b != bcur) { bcur = b;
#pragma unroll
            for (int j = 0; j < 4; ++j) gf[j] = *(const f32x4*)(MODS + ((DEPTH - 1) * 8 + b) * 6144 + 5 * 1024 + 4 * c.lane + 256 * j); }
        f32x4 v[RB][4];
#pragma unroll
        for (int i = 0; i < RB; ++i) load_row_bf(XR + (size_t)(m0 + i) * DM, c.lane, v[i]);
        moe_combine<RB>(c, m0, gf, v);
#pragma unroll
        for (int i = 0; i < RB; ++i) { const int m = m0 + i; const float r = row_rinv(v[i], c.lane);
#pragma unroll
            for (int j = 0; j < 4; ++j) { const int o = 4 * c.lane + 256 * j; *(f32x4*)(p->out + (size_t)m * DM + o) = v[i][j] * r * wf[j]; } }
    }
}

DI void prep_rows(KP p, const Ctx& c, int layer) {
    const bf16_t* PROJ = (const bf16_t*)(c.ws + WS_PROJ); bf16_t* CQN = (bf16_t*)(c.ws + WS_CQN); bf16_t* CKVN = (bf16_t*)(c.ws + WS_CKVN); bf16_t* KR = (bf16_t*)(c.ws + WS_KR);
    const float* ROPE = (const float*)(c.ws + WS_ROPE);
    const f32x4 gq = *(const f32x4*)(p->q_norm + layer * 256 + 4 * c.lane); const f32x2 gk = *(const f32x2*)(p->kv_norm + layer * 128 + 2 * c.lane);
    constexpr int RB = 4;
    for (int mm = c.lw * RB; mm < c.rcnt; mm += c.NLW * RB) { const int m0 = c.rbase + mm;
        u32x2 wq[RB]; unsigned wk[RB]; float r1[RB], r2[RB], rc[RB], rs[RB];
        const int l16 = c.lane & 15;
#pragma unroll
        for (int i = 0; i < RB; ++i) { const bf16_t* pr = PROJ + (size_t)(m0 + i) * D_INP;
            wq[i] = *(const u32x2*)(pr + PC_CQ + 4 * c.lane); wk[i] = *(const unsigned*)(pr + PC_CKV + 2 * c.lane);
            r1[i] = bf1(pr[PC_KR + l16]); r2[i] = bf1(pr[PC_KR + 16 + l16]); rc[i] = ROPE[(m0 + i) * 32 + l16]; rs[i] = ROPE[(m0 + i) * 32 + 16 + l16]; }
#pragma unroll
        for (int i = 0; i < RB; ++i) { const int m = m0 + i;
            { const float x0 = bflo(wq[i].x), x1 = bfhi(wq[i].x), x2 = bflo(wq[i].y), x3 = bfhi(wq[i].y);
              const float s = wave_sum(x0 * x0 + x1 * x1 + x2 * x2 + x3 * x3, c.lane); const float r = 1.0f / sqrtf(s * (1.0f / 256.0f) + EPS);
              const float rs_ = r * X_SCALE; *(unsigned*)((unsigned char*)CQN + (size_t)m * 256 + 4 * c.lane) = pk4_fp8(x0 * rs_ * gq[0], x1 * rs_ * gq[1], x2 * rs_ * gq[2], x3 * rs_ * gq[3]); }
            { const float x0 = bflo(wk[i]), x1 = bfhi(wk[i]);
              const float s = wave_sum(x0 * x0 + x1 * x1, c.lane); const float r = 1.0f / sqrtf(s * (1.0f / 128.0f) + EPS);
              const float rs_ = r * X_SCALE; *(unsigned short*)((unsigned char*)CKVN + (size_t)m * 256 + 2 * c.lane) = (unsigned short)(pk4_fp8(x0 * rs_ * gk[0], x1 * rs_ * gk[1], 0.f, 0.f) & 0xffffu);
              *(unsigned short*)((unsigned char*)CKVN + (size_t)m * 256 + 128 + 2 * c.lane) = (unsigned short)0; }
            if (c.lane < 16) { KR[(size_t)m * 32 + c.lane] = (bf16_t)(cvtpk(r1[i] * rc[i] - r2[i] * rs[i], 0.f) & 0xffffu); KR[(size_t)m * 32 + 16 + c.lane] = (bf16_t)(cvtpk(r2[i] * rc[i] + r1[i] * rs[i], 0.f) & 0xffffu); }
        }
    }
}
constexpr int SC_LD = 2052;
DI unsigned okey(float f) { const unsigned u = __float_as_uint(f); return (u & 0x80000000u) ? ~u : (u | 0x80000000u); }
DI void idx_load(const Ctx& c, int b, int g, bf16x8 (&qf)[8][2], u32x4& wraw, bf16x8 (&ka)[8][2]) {
    const bf16_t* PROJ = (const bf16_t*)(c.ws + WS_PROJ);
    const int qbase = 16 * g, nkb = 4 * ((g >> 2) + 1); const int l15 = c.lane & 15, l4 = c.lane >> 4;
    const bf16_t* qrow = PROJ + (size_t)(b * SEQ + qbase + l15) * D_INP;
#pragma unroll
    for (int h = 0; h < 8; ++h)
#pragma unroll
        for (int ks = 0; ks < 2; ++ks) qf[h][ks] = *(const bf16x8*)(qrow + PC_QI + 64 * h + 32 * ks + 8 * l4);
    wraw = *(const u32x4*)(qrow + PC_WI);
    const bf16_t* kbase = PROJ + (size_t)(b * SEQ + l15) * D_INP + PC_KI + 8 * l4; const size_t kstride = (size_t)16 * D_INP;
#pragma unroll
    for (int d = 0; d < 8; ++d) { const int kb = c.wave + 8 * d; const int kc = kb < nkb ? kb : 0; ka[d][0] = *(const bf16x8*)(kbase + kc * kstride); ka[d][1] = *(const bf16x8*)(kbase + kc * kstride + 32); }
}
DI void idx_scores(const Ctx& c, int b, int g, const bf16x8 (&qf)[8][2], const u32x4& w, bf16x8 (&ka)[8][2]) {
    const bf16_t* PROJ = (const bf16_t*)(c.ws + WS_PROJ); LAS float* sc = (LAS float*)c.lds;
    const int nkb = 4 * ((g >> 2) + 1); const int l15 = c.lane & 15, l4 = c.lane >> 4;
    const float wh[8] = {bflo(w.x), bfhi(w.x), bflo(w.y), bfhi(w.y), bflo(w.z), bfhi(w.z), bflo(w.w), bfhi(w.w)};
    const bf16_t* kbase = PROJ + (size_t)(b * SEQ + l15) * D_INP + PC_KI + 8 * l4; const size_t kstride = (size_t)16 * D_INP;
    const int nmine = (nkb - c.wave + 7) >> 3;
#pragma unroll 1
    for (int i0 = 0; i0 < nmine; i0 += 8) {
        if (i0 > 0) {
#pragma unroll
            for (int d = 0; d < 8; ++d) { const int kb = c.wave + 8 * (i0 + d); const int kc = kb < nkb ? kb : 0; ka[d][0] = *(const bf16x8*)(kbase + kc * kstride); ka[d][1] = *(const bf16x8*)(kbase + kc * kstride + 32); } }
#pragma unroll
        for (int d = 0; d < 8; ++d) { const int i = i0 + d; if (i < nmine) {
            const int kb = c.wave + 8 * i;
            f32x4 s = {0.f, 0.f, 0.f, 0.f};
#pragma unroll
            for (int h = 0; h < 8; ++h) { f32x4 a = {0.f, 0.f, 0.f, 0.f};
                a = __builtin_amdgcn_mfma_f32_16x16x32_bf16(ka[d][0], qf[h][0], a, 0, 0, 0);
                a = __builtin_amdgcn_mfma_f32_16x16x32_bf16(ka[d][1], qf[h][1], a, 0, 0, 0);
#pragma unroll
                for (int e = 0; e < 4; ++e) s[e] += wh[h] * fmaxf(a[e], 0.f); }
            *(LAS f32x4*)(sc + l15 * SC_LD + 16 * kb + 4 * l4) = s; } }
    }
}
#define SEL_CMP8(OP) asm(OP " %0, %8, %16\n\t" OP " %1, %9, %16\n\t" OP " %2, %10, %16\n\t" OP " %3, %11, %16\n\t" OP " %4, %12, %16\n\t" OP " %5, %13, %16\n\t" OP " %6, %14, %16\n\t" OP " %7, %15, %16" \
        : "=&s"(m0), "=&s"(m1), "=&s"(m2), "=&s"(m3), "=&s"(m4), "=&s"(m5), "=&s"(m6), "=&s"(m7) \
        : "v"(u[g]), "v"(u[g + 1]), "v"(u[g + 2]), "v"(u[g + 3]), "v"(u[g + 4]), "v"(u[g + 5]), "v"(u[g + 6]), "v"(u[g + 7]), "v"(cand))
DI unsigned ikey(unsigned k) { return (k & 0x80000000u) ? (k & 0x7fffffffu) : ~k; }
DI int sel_count_ge(const unsigned (&u)[32], unsigned ckey, int nj) {
    int cnt = 0; const unsigned cand = ikey(ckey);
#pragma unroll
    for (int g = 0; g < 32; g += 8) if (g < nj) { unsigned long long m0, m1, m2, m3, m4, m5, m6, m7; SEL_CMP8("v_cmp_ge_f32_e64");
        cnt += (__builtin_popcountll(m0) + __builtin_popcountll(m1)) + (__builtin_popcountll(m2) + __builtin_popcountll(m3)) + (__builtin_popcountll(m4) + __builtin_popcountll(m5)) + (__builtin_popcountll(m6) + __builtin_popcountll(m7)); }
    return cnt;
}
DI int sel_count_gt(const unsigned (&u)[32], unsigned ckey) {
    int cnt = 0; const unsigned cand = ikey(ckey);
#pragma unroll
    for (int g = 0; g < 32; g += 8) { unsigned long long m0, m1, m2, m3, m4, m5, m6, m7; SEL_CMP8("v_cmp_gt_f32_e64");
        cnt += (__builtin_popcountll(m0) + __builtin_popcountll(m1)) + (__builtin_popcountll(m2) + __builtin_popcountll(m3)) + (__builtin_popcountll(m4) + __builtin_popcountll(m5)) + (__builtin_popcountll(m6) + __builtin_popcountll(m7)); }
    return cnt;
}
DI void idx_select(const Ctx& c, int b, int g) {
    unsigned long long* MASK = (unsigned long long*)(c.ws + WS_MASK); LAS float* sc = (LAS float*)c.lds;
    const int qbase = 16 * g, nvis = 64 * ((g >> 2) + 1);
    {
        const int nj = nvis >> 6;
        for (int qq = 0; qq < 2; ++qq) {
            const int q = 2 * c.wave + qq; const LAS float* row = sc + q * SC_LD;
            int wlo = 0, whi = 0;
            if (nvis <= 256) { wlo = whi = (c.lane < nj) ? -1 : 0; }
            else {
                unsigned u[32]; float fmx = -INFINITY;
#pragma unroll
                for (int j = 0; j < 32; ++j) { const float f = (j < nj) ? row[64 * j + c.lane] : -INFINITY; u[j] = __float_as_uint(f); fmx = fmaxf(fmx, f); }
                fmx = fmaxf(fmx, __int_as_float(__builtin_amdgcn_update_dpp(__float_as_int(fmx), __float_as_int(fmx), 0xB1, 0xF, 0xF, false)));
                fmx = fmaxf(fmx, __int_as_float(__builtin_amdgcn_update_dpp(__float_as_int(fmx), __float_as_int(fmx), 0x4E, 0xF, 0xF, false)));
                fmx = fmaxf(fmx, __int_as_float(__builtin_amdgcn_update_dpp(__float_as_int(fmx), __float_as_int(fmx), 0x141, 0xF, 0xF, false)));
                fmx = fmaxf(fmx, __int_as_float(__builtin_amdgcn_update_dpp(__float_as_int(fmx), __float_as_int(fmx), 0x140, 0xF, 0xF, false)));
                const float fm01 = fmaxf(__int_as_float(__builtin_amdgcn_readlane(__float_as_int(fmx), 0)), __int_as_float(__builtin_amdgcn_readlane(__float_as_int(fmx), 16)));
                const float fm23 = fmaxf(__int_as_float(__builtin_amdgcn_readlane(__float_as_int(fmx), 32)), __int_as_float(__builtin_amdgcn_readlane(__float_as_int(fmx), 48)));
                const unsigned umax = okey(fmaxf(fm01, fm23));
                unsigned T = umax & 0xff800000u; bool exact = false; bool found = false;
                for (int st = 0; st < 3; ++st) { const int cnt = sel_count_ge(u, T, nj);
                    if (cnt >= 256) { found = true; exact = cnt == 256; break; }
                    if (st < 2 && T >= (1u << 23)) T -= 1u << 23; }
                if (!found) { unsigned lo9 = 0u, hi9 = T >> 23;
                    while (hi9 - lo9 > 1u) { const unsigned mid = (lo9 + hi9) >> 1; const int cnt = sel_count_ge(u, mid << 23, nj);
                        if (cnt >= 256) { lo9 = mid; if (cnt == 256) { exact = true; break; } } else hi9 = mid; }
                    T = lo9 << 23; }
                if (!exact)
                for (int bit = 22; bit >= 0; --bit) {
                    const unsigned cand = T | (1u << bit);
                    const int cnt = sel_count_ge(u, cand, nj);
                    if (cnt >= 256) { T = cand; if (cnt == 256) { exact = true; break; } }
                }
                if (exact) {
                    const unsigned cand = ikey(T);
#pragma unroll
                    for (int g = 0; g < 32; g += 8) if (g < nj) { unsigned long long m0, m1, m2, m3, m4, m5, m6, m7; SEL_CMP8("v_cmp_ge_f32_e64");
                        asm("v_writelane_b32 %0, %2, %18\n\tv_writelane_b32 %1, %3, %18\n\tv_writelane_b32 %0, %4, %19\n\tv_writelane_b32 %1, %5, %19\n\tv_writelane_b32 %0, %6, %20\n\tv_writelane_b32 %1, %7, %20\n\tv_writelane_b32 %0, %8, %21\n\tv_writelane_b32 %1, %9, %21\n\t"
                            "v_writelane_b32 %0, %10, %22\n\tv_writelane_b32 %1, %11, %22\n\tv_writelane_b32 %0, %12, %23\n\tv_writelane_b32 %1, %13, %23\n\tv_writelane_b32 %0, %14, %24\n\tv_writelane_b32 %1, %15, %24\n\tv_writelane_b32 %0, %16, %25\n\tv_writelane_b32 %1, %17, %25"
                            : "+v"(wlo), "+v"(whi)
                            : "s"((int)(unsigned)m0), "s"((int)(unsigned)(m0 >> 32)), "s"((int)(unsigned)m1), "s"((int)(unsigned)(m1 >> 32)), "s"((int)(unsigned)m2), "s"((int)(unsigned)(m2 >> 32)), "s"((int)(unsigned)m3), "s"((int)(unsigned)(m3 >> 32)),
                              "s"((int)(unsigned)m4), "s"((int)(unsigned)(m4 >> 32)), "s"((int)(unsigned)m5), "s"((int)(unsigned)(m5 >> 32)), "s"((int)(unsigned)m6), "s"((int)(unsigned)(m6 >> 32)), "s"((int)(unsigned)m7), "s"((int)(unsigned)(m7 >> 32)),
                              "n"(g), "n"(g + 1), "n"(g + 2), "n"(g + 3), "n"(g + 4), "n"(g + 5), "n"(g + 6), "n"(g + 7)); }
                } else {
                    const int need = 256 - sel_count_gt(u, T); int eqbase = 0; const float Tf = __uint_as_float(ikey(T));
#pragma unroll
                    for (int j = 0; j < 32; ++j) { const float uf = __uint_as_float(u[j]); const unsigned long long eq = __ballot(uf == Tf);
                        const int rank = eqbase + (int)__builtin_amdgcn_mbcnt_hi((unsigned)(eq >> 32), __builtin_amdgcn_mbcnt_lo((unsigned)eq, 0u));
                        const unsigned long long sel = __ballot(uf > Tf || (uf == Tf && rank < need)); eqbase += __builtin_popcountll(eq);
                        asm("s_nop 3\n\tv_writelane_b32 %0, %2, %4\n\tv_writelane_b32 %1, %3, %4" : "+v"(wlo), "+v"(whi) : "s"((int)(unsigned)sel), "s"((int)(unsigned)(sel >> 32)), "n"(j)); }
                }
            }
            if (c.lane < 32) MASK[(size_t)(b * SEQ + qbase + q) * 32 + c.lane] = ((unsigned long long)(unsigned)whi << 32) | (unsigned)wlo;
        }
    }
}
DI void phase_prep_indexer(KP p, const Ctx& c, int layer) {
    prep_rows(p, c, layer);
    for (int v = c.vcu; v < 256; v += c.G) { const int b = v >> 5, s = v & 31;
        bf16x8 qf[8][2]; u32x4 wraw; bf16x8 ka[8][2];
        idx_load(c, b, 127 - s, qf, wraw, ka);
#pragma unroll
        for (int i = 0; i < 4; ++i) { const int g = i == 0 ? 127 - s : (i == 1 ? 64 + s : (i == 2 ? 63 - s : s)); const int gn = i == 0 ? 64 + s : (i == 1 ? 63 - s : s);
            idx_scores(c, b, g, qf, wraw, ka);
            __syncthreads();
            if (i < 3) idx_load(c, b, gn, qf, wraw, ka);
            idx_select(c, b, g);
            __syncthreads(); }
    }
}

template <bool MLA>
DI void attn_unit(const Ctx& c, const float* rel_bias, int b, int h, int qb) {
    constexpr int NKS = MLA ? 6 : 4;
    constexpr int SLOTB = MLA ? 20480 : 20480;
    constexpr int XOFF = 8192, VOFF = 12288, NSLOT = 4, LUTOFF = NSLOT * SLOTB;
    const bf16_t* PROJ = (const bf16_t*)(c.ws + WS_PROJ); const bf16_t* UPO = (const bf16_t*)(c.ws + WS_UPO);
    const bf16_t* KRB = (const bf16_t*)(c.ws + WS_KR); const float* ROPE = (const float*)(c.ws + WS_ROPE);
    const unsigned long long* MASK = (const unsigned long long*)(c.ws + WS_MASK); bf16_t* YB = (bf16_t*)(c.ws + WS_YBUF);
    const int tid = c.tid, lane = c.lane, r32 = lane & 31, hi = lane >> 5, wid = c.wave;
    const int q0 = qb * 256, qw = q0 + 64 * ((wid >> 1) ^ (wid >> 2)) + 32 * (wid & 1), qglob = qw + r32; const size_t mrow = (size_t)b * SEQ + qglob;
    const int NT = 4 * (qb + 1), tmax = qw >> 6;
    const float cs = (MLA ? 0.10206207261596575f : 0.125f) * LOG2E;
    LAS unsigned char* lds = c.lds;
    const int dkey = 8 * wid + (lane >> 3), dpos = lane & 7;
    const int kchunk = dpos ^ ((dkey >> 1) & 7), vchunk = dpos ^ (((dkey >> 1) & 1) << 2);
    const char *ksrc, *vsrc, *xsrc; size_t tstepK, tstepX;
    if constexpr (MLA) { const bf16_t* rowp = UPO + ((size_t)b * SEQ + dkey) * UPO_LD + 768 + 128 * h; ksrc = (const char*)(rowp + 8 * kchunk); vsrc = (const char*)(rowp + 64 + 8 * vchunk);
        const int xkey = 16 * (wid & 3) + (lane >> 2), xpos = lane & 3;
        xsrc = (const char*)(KRB + ((size_t)b * SEQ + xkey) * 32 + 8 * (xpos ^ ((xkey >> 2) & 3))); tstepK = (size_t)64 * UPO_LD * 2; tstepX = 64 * 32 * 2; }
    else { const bf16_t* rowp = PROJ + ((size_t)b * SEQ + dkey) * D_INP + 64 * h; ksrc = (const char*)(rowp + PC_KA + 8 * kchunk); vsrc = (const char*)(rowp + PC_VA + 8 * vchunk);
        xsrc = (const char*)(MASK + mrow * 32); tstepK = (size_t)64 * D_INP * 2; tstepX = 8; }
    const unsigned wbase = (unsigned)wid * 1024u;
#define A_DMA(t) do { const int t_ = (t); const unsigned so_ = (unsigned)(t_ & 3) * SLOTB; \
        __builtin_amdgcn_global_load_lds((const unsigned*)(ksrc + (size_t)t_ * tstepK), (LAS unsigned*)(lds + so_ + wbase), 16, 0, 0); \
        __builtin_amdgcn_global_load_lds((const unsigned*)(vsrc + (size_t)t_ * tstepK), (LAS unsigned*)(lds + so_ + VOFF + wbase), 16, 0, 0); \
        if constexpr (MLA) { if (wid < 4) __builtin_amdgcn_global_load_lds((const unsigned*)(xsrc + (size_t)t_ * tstepX), (LAS unsigned*)(lds + so_ + XOFF + wbase), 16, 0, 0); } \
        else { __builtin_amdgcn_global_load_lds((const unsigned*)(xsrc + (size_t)t_ * tstepX), (LAS unsigned*)(lds + so_ + XOFF + (unsigned)wid * 512u), 4, 0, 0); \
               __builtin_amdgcn_global_load_lds((const unsigned*)(xsrc + (size_t)t_ * tstepX + 4), (LAS unsigned*)(lds + so_ + XOFF + (unsigned)wid * 512u + 256u), 4, 0, 0); } } while (0)
#define A_WAITBAR(n_) do { if constexpr (!MLA) { if ((n_) == 2) asm volatile("s_waitcnt vmcnt(8)" ::: "memory"); else if ((n_) == 1) asm volatile("s_waitcnt vmcnt(4)" ::: "memory"); else asm volatile("s_waitcnt vmcnt(0)" ::: "memory"); } \
        else if (wid < 4) { if ((n_) == 2) asm volatile("s_waitcnt vmcnt(6)" ::: "memory"); else if ((n_) == 1) asm volatile("s_waitcnt vmcnt(3)" ::: "memory"); else asm volatile("s_waitcnt vmcnt(0)" ::: "memory"); } \
        else { if ((n_) == 2) asm volatile("s_waitcnt vmcnt(4)" ::: "memory"); else if ((n_) == 1) asm volatile("s_waitcnt vmcnt(2)" ::: "memory"); else asm volatile("s_waitcnt vmcnt(0)" ::: "memory"); } \
        __builtin_amdgcn_s_barrier(); asm volatile("" ::: "memory"); } while (0)
    A_DMA(0); A_DMA(1);
    bf16x8 qr[NKS];
    {
        const bf16_t* qrow = MLA ? UPO + mrow * UPO_LD + 96 * h : PROJ + mrow * D_INP + PC_QA + 64 * h;
        u32x4 wq[4], w1 = {0u, 0u, 0u, 0u}, w2 = {0u, 0u, 0u, 0u}; f32x4 c0 = {}, c1 = {}, s0 = {}, s1 = {};
#pragma unroll
        for (int j = 0; j < 4; ++j) wq[j] = *(const u32x4*)(qrow + 16 * j + 8 * hi);
        if constexpr (MLA) { w1 = *(const u32x4*)(qrow + 64 + 8 * hi); w2 = *(const u32x4*)(qrow + 80 + 8 * hi);
            const float* rp = ROPE + mrow * 32 + 8 * hi; c0 = *(const f32x4*)(rp); c1 = *(const f32x4*)(rp + 4); s0 = *(const f32x4*)(rp + 16); s1 = *(const f32x4*)(rp + 20); }
        float c15v = 0.f, lutv = 0.f;
        if constexpr (!MLA) { c15v = rel_bias[15 * 8 + h];
            if (tid < 255) { const int rel = tid - 191; const int n = rel < 0 ? -rel : rel;
                int bk = n < 8 ? n : (n < 12 ? 8 : (n < 16 ? 9 : (n < 23 ? 10 : (n < 32 ? 11 : (n < 46 ? 12 : (n < 64 ? 13 : (n < 91 ? 14 : 15)))))));
                if (rel > 0) bk += 16;
                lutv = rel_bias[bk * 8 + h]; } }
        asm volatile("s_waitcnt vmcnt(0)" ::: "memory");
#pragma unroll
        for (int j = 0; j < 4; ++j) { const u32x4 w = wq[j]; u32x4 o;
            o.x = cvtpk(bflo(w.x) * cs, bfhi(w.x) * cs); o.y = cvtpk(bflo(w.y) * cs, bfhi(w.y) * cs); o.z = cvtpk(bflo(w.z) * cs, bfhi(w.z) * cs); o.w = cvtpk(bflo(w.w) * cs, bfhi(w.w) * cs);
            qr[j] = __builtin_bit_cast(bf16x8, o); }
        if constexpr (MLA) {
            float x1[8] = {bflo(w1.x), bfhi(w1.x), bflo(w1.y), bfhi(w1.y), bflo(w1.z), bfhi(w1.z), bflo(w1.w), bfhi(w1.w)};
            float x2[8] = {bflo(w2.x), bfhi(w2.x), bflo(w2.y), bfhi(w2.y), bflo(w2.z), bfhi(w2.z), bflo(w2.w), bfhi(w2.w)};
            float y1[8], y2[8];
#pragma unroll
            for (int e = 0; e < 8; ++e) { const float cc = e < 4 ? c0[e & 3] : c1[e & 3], ss = e < 4 ? s0[e & 3] : s1[e & 3];
                y1[e] = (x1[e] * cc - x2[e] * ss) * cs; y2[e] = (x2[e] * cc + x1[e] * ss) * cs; }
            u32x4 o1, o2; o1.x = cvtpk(y1[0], y1[1]); o1.y = cvtpk(y1[2], y1[3]); o1.z = cvtpk(y1[4], y1[5]); o1.w = cvtpk(y1[6], y1[7]);
            o2.x = cvtpk(y2[0], y2[1]); o2.y = cvtpk(y2[2], y2[3]); o2.z = cvtpk(y2[4], y2[5]); o2.w = cvtpk(y2[6], y2[7]);
            qr[4] = __builtin_bit_cast(bf16x8, o1); qr[5] = __builtin_bit_cast(bf16x8, o2);
        } else {
            if (tid < 255) ((LAS float*)(lds + LUTOFF))[tid] = lutv * LOG2E;
        }
        c15v *= LOG2E;
        float M = 0.f, lrun = 0.f; bool fresh = true; f32x16 o0 = {}, o1 = {};
        const bf16x8 kx = __builtin_bit_cast(bf16x8, (u32x4){hi == 0 ? 0x3f80u : 0u, 0u, 0u, 0u}); bf16x8 qx = __builtin_bit_cast(bf16x8, (u32x4){0u, 0u, 0u, 0u});
        int kfo[NKS];
#pragma unroll
        for (int j = 0; j < NKS; ++j) kfo[j] = (MLA && j >= 4) ? XOFF + r32 * 64 + (((2 * (j - 4) + hi) ^ ((r32 >> 2) & 3)) << 4) : r32 * 128 + (((2 * j + hi) ^ ((r32 >> 1) & 7)) << 4);
        const int vq = (lane & 15) >> 2, vf = ((vq >> 1) & 1) << 2;
        const int vfo0 = VOFF + (4 * hi + vq) * 128 + ((0 ^ vf) << 4) + ((lane >> 4) & 1) * 32 + (lane & 3) * 8;
        const int vfo1 = VOFF + (4 * hi + vq) * 128 + ((4 ^ vf) << 4) + ((lane >> 4) & 1) * 32 + (lane & 3) * 8;
        for (int t = 0; t < NT; ++t) {
            if (t + 2 < NT) { A_DMA(t + 2); A_WAITBAR(2); } else if (t + 1 < NT) { A_WAITBAR(1); } else { A_WAITBAR(0); }
            if (t <= tmax) {
                const LAS unsigned char* sl = lds + (t & 3) * SLOTB;
                f32x16 s0v, s1v;
                if constexpr (!MLA) {
                    if (64 * t > qw - 154) { const LAS float* lut = (const LAS float*)(lds + LUTOFF); const int base = 64 * t - qglob + 191 + 4 * hi;
#pragma unroll
                        for (int r = 0; r < 16; ++r) { const int o = base + (r & 3) + 8 * (r >> 2); s0v[r] = lut[o]; s1v[r] = lut[o + 32]; } }
                    else {
#pragma unroll
                        for (int r = 0; r < 16; ++r) { s0v[r] = c15v; s1v[r] = c15v; } }
                } else {
#pragma unroll
                    for (int r = 0; r < 16; ++r) { s0v[r] = 0.f; s1v[r] = 0.f; }
                }
                bf16x8 kfa[NKS], kfb[NKS];
#pragma unroll
                for (int j = 0; j < NKS; ++j) { kfa[j] = *(const LAS bf16x8*)(sl + kfo[j]); kfb[j] = *(const LAS bf16x8*)(sl + kfo[j] + ((MLA && j >= 4) ? 2048 : 4096)); }
                __builtin_amdgcn_sched_barrier(0);
#pragma unroll
                for (int j = 0; j < NKS; ++j) { s0v = __builtin_amdgcn_mfma_f32_32x32x16_bf16(kfa[j], qr[j], s0v, 0, 0, 0); s1v = __builtin_amdgcn_mfma_f32_32x32x16_bf16(kfb[j], qr[j], s1v, 0, 0, 0); }
                s0v = __builtin_amdgcn_mfma_f32_32x32x16_bf16(kx, qx, s0v, 0, 0, 0); s1v = __builtin_amdgcn_mfma_f32_32x32x16_bf16(kx, qx, s1v, 0, 0, 0);
                s16x4 vlo[8], vhi[8]; { const unsigned va0_ = (unsigned)(size_t)(sl + vfo0), va1_ = (unsigned)(size_t)(sl + vfo1);
#pragma unroll
                    for (int i = 0; i < 4; ++i) { asm volatile("ds_read_b64_tr_b16 %0, %1 offset:%2" : "=&v"(vlo[i]) : "v"(va0_), "n"(i * 2048) : "memory");
                        asm volatile("ds_read_b64_tr_b16 %0, %1 offset:%2" : "=&v"(vhi[i]) : "v"(va0_), "n"(i * 2048 + 1024) : "memory");
                        asm volatile("ds_read_b64_tr_b16 %0, %1 offset:%2" : "=&v"(vlo[4 + i]) : "v"(va1_), "n"(i * 2048) : "memory");
                        asm volatile("ds_read_b64_tr_b16 %0, %1 offset:%2" : "=&v"(vhi[4 + i]) : "v"(va1_), "n"(i * 2048 + 1024) : "memory"); } }
                if constexpr (!MLA) { const LAS unsigned* mw = (const LAS unsigned*)(sl + XOFF + wid * 512 + r32 * 4);
                    const unsigned wl = mw[0] >> (4 * hi), wh = mw[64] >> (4 * hi);
#pragma unroll
                    for (int r = 0; r < 16; ++r) { const int bit = (r & 3) + 8 * (r >> 2);
                        const unsigned t0 = (unsigned)__builtin_amdgcn_sbfe((int)wl, bit, 1), t1 = (unsigned)__builtin_amdgcn_sbfe((int)wh, bit, 1);
                        s0v[r] = __uint_as_float((__float_as_uint(s0v[r]) & t0) | (0xff800000u & ~t0)); s1v[r] = __uint_as_float((__float_as_uint(s1v[r]) & t1) | (0xff800000u & ~t1)); } }
                float mx;
                { float ma, mb;
#define MAX3(d, a, b, c) asm("v_max3_f32 %0, %1, %2, %3" : "=v"(d) : "v"(a), "v"(b), "v"(c))
                  asm("s_nop 15\n\ts_nop 3\n\tv_max3_f32 %0, %2, %3, %4\n\tv_max3_f32 %1, %5, %6, %7" : "=&v"(ma), "=&v"(mb) : "v"(s0v[0]), "v"(s0v[1]), "v"(s0v[2]), "v"(s1v[0]), "v"(s1v[1]), "v"(s1v[2]));
#pragma unroll
                  for (int r = 3; r < 15; r += 2) { MAX3(ma, ma, s0v[r], s0v[r + 1]); MAX3(mb, mb, s1v[r], s1v[r + 1]); }
                  MAX3(ma, ma, mb, s0v[15]); MAX3(mx, ma, s1v[15], s1v[15]);
#undef MAX3
                }
                mx = xor32_max(mx);
                {
                    const bool finite = mx > -INFINITY; const bool upd = finite && (mx > 8.f || fresh);
                    if (__builtin_amdgcn_ballot_w64(upd) != 0ull) {
                        const float Mx = M + mx; const unsigned ub = __float_as_uint(Mx);
                        const float Mn = upd ? __uint_as_float(Mx >= 0.f ? ((ub + 0xffffu) & 0xffff0000u) : (ub & 0xffff0000u)) : M;
                        const float delta = Mn - M; const float alpha = fresh ? 0.f : __builtin_amdgcn_exp2f(-delta);
                        M = Mn; lrun *= alpha;
#pragma unroll
                        for (int r = 0; r < 16; ++r) { o0[r] *= alpha; o1[r] *= alpha; s0v[r] -= delta; s1v[r] -= delta; }
                        qx = __builtin_bit_cast(bf16x8, (u32x4){hi == 0 ? ((__float_as_uint(M) ^ 0x80000000u) >> 16) : 0u, 0u, 0u, 0u});
                    }
                    fresh = fresh && !finite;
                }
                float ls = 0.f;
#pragma unroll
                for (int r = 0; r < 16; ++r) { s0v[r] = __builtin_amdgcn_exp2f(s0v[r]); s1v[r] = __builtin_amdgcn_exp2f(s1v[r]); ls += s0v[r] + s1v[r]; }
                lrun += ls;
                bf16x8 pf[4];
                { u32x4 w;
                  w.x = cvtpk(s0v[0], s0v[1]); w.y = cvtpk(s0v[2], s0v[3]); w.z = cvtpk(s0v[4], s0v[5]); w.w = cvtpk(s0v[6], s0v[7]); pf[0] = __builtin_bit_cast(bf16x8, w);
                  w.x = cvtpk(s0v[8], s0v[9]); w.y = cvtpk(s0v[10], s0v[11]); w.z = cvtpk(s0v[12], s0v[13]); w.w = cvtpk(s0v[14], s0v[15]); pf[1] = __builtin_bit_cast(bf16x8, w);
                  w.x = cvtpk(s1v[0], s1v[1]); w.y = cvtpk(s1v[2], s1v[3]); w.z = cvtpk(s1v[4], s1v[5]); w.w = cvtpk(s1v[6], s1v[7]); pf[2] = __builtin_bit_cast(bf16x8, w);
                  w.x = cvtpk(s1v[8], s1v[9]); w.y = cvtpk(s1v[10], s1v[11]); w.z = cvtpk(s1v[12], s1v[13]); w.w = cvtpk(s1v[14], s1v[15]); pf[3] = __builtin_bit_cast(bf16x8, w); }
                asm volatile("s_waitcnt lgkmcnt(0)" : "+v"(vlo[0]), "+v"(vlo[1]), "+v"(vlo[2]), "+v"(vlo[3]), "+v"(vlo[4]), "+v"(vlo[5]), "+v"(vlo[6]), "+v"(vlo[7]),
                             "+v"(vhi[0]), "+v"(vhi[1]), "+v"(vhi[2]), "+v"(vhi[3]), "+v"(vhi[4]), "+v"(vhi[5]), "+v"(vhi[6]), "+v"(vhi[7]) :: "memory");
#pragma unroll
                for (int ks = 0; ks < 4; ++ks) {
                    const bf16x8 va = __builtin_shufflevector(vlo[ks], vhi[ks], 0, 1, 2, 3, 4, 5, 6, 7), vb = __builtin_shufflevector(vlo[4 + ks], vhi[4 + ks], 0, 1, 2, 3, 4, 5, 6, 7);
                    o0 = __builtin_amdgcn_mfma_f32_32x32x16_bf16(va, pf[ks], o0, 0, 0, 0);
                    o1 = __builtin_amdgcn_mfma_f32_32x32x16_bf16(vb, pf[ks], o1, 0, 0, 0);
                }
            }
        }
        lrun = xor32_sum(lrun);
        const float inv = 1.0f / lrun;
        unsigned char* yrow = (unsigned char*)YB + mrow * DM + (MLA ? 512 : 0) + 64 * h + 4 * hi;
        const float ys = inv * Y_SCALE;
#pragma unroll
        for (int g = 0; g < 4; ++g) {
            *(unsigned*)(yrow + 8 * g) = pk4_fp8(o0[4 * g] * ys, o0[4 * g + 1] * ys, o0[4 * g + 2] * ys, o0[4 * g + 3] * ys);
            *(unsigned*)(yrow + 32 + 8 * g) = pk4_fp8(o1[4 * g] * ys, o1[4 * g + 1] * ys, o1[4 * g + 2] * ys, o1[4 * g + 3] * ys); }
    }
    asm volatile("s_waitcnt vmcnt(0) lgkmcnt(0)" ::: "memory"); __builtin_amdgcn_s_barrier(); asm volatile("" ::: "memory");
#undef A_DMA
#undef A_WAITBAR
}
DI void phase_attention(KP p, const Ctx& c) {
    for (int v = c.vcu; v < 256; v += c.G) { const int bh = v >> 2, s = v & 3, b = bh >> 3, h = bh & 7;
        for (int rep_ = 0; rep_ < (PROBE_X == 4 ? 2 : 1); ++rep_) attn_unit<false>(c, p->rel_bias, b, h, 7 - s);
        for (int rep_ = 0; rep_ < (PROBE_X == 5 ? 2 : 1); ++rep_) attn_unit<true>(c, p->rel_bias, b, h, 7 - s);
        for (int rep_ = 0; rep_ < (PROBE_X == 4 ? 2 : 1); ++rep_) attn_unit<false>(c, p->rel_bias, b, h, s);
        for (int rep_ = 0; rep_ < (PROBE_X == 5 ? 2 : 1); ++rep_) attn_unit<true>(c, p->rel_bias, b, h, s); }
}

DI void phase_router(KP p, const Ctx& c, int layer) {
    const bf16_t* XR = (const bf16_t*)(c.ws + WS_XR); unsigned char* HB8 = c.ws + WS_XP8; const float* MODS = (const float*)(c.ws + WS_MODS);
    int* ME = (int*)(c.ws + WS_ME); int* MR = (int*)(c.ws + WS_MR); float* MG = (float*)(c.ws + WS_MG);
    unsigned* gcnt = (unsigned*)(c.ws + WS_CTL) + CW_GCNT + layer * 64;
    constexpr int HS_LD = 1025;
    LAS float* hs = (LAS float*)c.lds;
    LAS float* red = (LAS float*)c.lds;
    LAS float* logit = (LAS float*)(c.lds + 34816);
    LAS int* lcnt = (LAS int*)(c.lds + LC_MISC);
    const float* wr_ = p->w_router + (size_t)layer * 1024 * 32; const float* br_ = p->b_router + layer * 32;
    const int r32 = c.lane & 31, hi = c.lane >> 5;
    bf16x8 wh[8], wl[8];
    { float wv[64];
#pragma unroll
      for (int kk = 0; kk < 64; ++kk) wv[kk] = wr_[(c.wave * 128 + 16 * (kk >> 3) + 8 * hi + (kk & 7)) * 32 + r32];
#pragma unroll
      for (int ks = 0; ks < 8; ++ks) { u32x4 oh, ol;
#pragma unroll
          for (int q = 0; q < 4; ++q) { const float x0 = wv[8 * ks + 2 * q], x1 = wv[8 * ks + 2 * q + 1];
              const unsigned h0 = __float_as_uint(x0) & 0xffff0000u, h1 = __float_as_uint(x1) & 0xffff0000u;
              oh[q] = h1 | (h0 >> 16); ol[q] = cvtpk(x0 - __uint_as_float(h0), x1 - __uint_as_float(h1)); }
          wh[ks] = __builtin_bit_cast(bf16x8, oh); wl[ks] = __builtin_bit_cast(bf16x8, ol); } }
    const float brv = br_[c.tid & 31];
    for (int blk = c.vcu; blk < NTOK / 64; blk += c.G) {
        ModVec mv; { const int b = (blk * 64) >> 11; const float* md = MODS + (layer * 8 + b) * 6144 + 3 * 1024; modvec_load(p->norm_ffn + layer * 1024, md, md + 1024, c.lane, mv); }
        if (c.tid < 32) lcnt[c.tid] = 0;
        __syncthreads();
        for (int grp = 0; grp < 2; ++grp) {
            const int m0 = blk * 64 + grp * 32;
            { f32x4 v[4][4];
#pragma unroll
              for (int i = 0; i < 4; ++i) load_row_bf(XR + (size_t)(m0 + c.wave * 4 + i) * DM, c.lane, v[i]);
#pragma unroll
              for (int i = 0; i < 4; ++i) { const int tl = c.wave * 4 + i, m = m0 + tl; f32x4 h[4];
                const float r = row_rinv(v[i], c.lane);
                modulate(v[i], r, mv, h);
#pragma unroll
                for (int j = 0; j < 4; ++j) *(unsigned*)(HB8 + (size_t)m * DM + 4 * c.lane + 256 * j) = pk4_fp8(h[j][0] * X_SCALE, h[j][1] * X_SCALE, h[j][2] * X_SCALE, h[j][3] * X_SCALE);
#pragma unroll
                for (int j = 0; j < 4; ++j)
#pragma unroll
                    for (int e = 0; e < 4; ++e) hs[tl * HS_LD + 4 * c.lane + 256 * j + e] = h[j][e]; } }
            __syncthreads();
            f32x16 acc = {};
#pragma unroll
            for (int ks = 0; ks < 8; ++ks) { const LAS float* xr = hs + r32 * HS_LD + c.wave * 128 + 16 * ks + 8 * hi; u32x4 oh, ol;
#pragma unroll
                for (int q = 0; q < 4; ++q) { const float x0 = xr[2 * q], x1 = xr[2 * q + 1];
                    const unsigned h0 = __float_as_uint(x0) & 0xffff0000u, h1 = __float_as_uint(x1) & 0xffff0000u;
                    oh[q] = h1 | (h0 >> 16); ol[q] = cvtpk(x0 - __uint_as_float(h0), x1 - __uint_as_float(h1)); }
                const bf16x8 ah = __builtin_bit_cast(bf16x8, oh), al = __builtin_bit_cast(bf16x8, ol);
                acc = __builtin_amdgcn_mfma_f32_32x32x16_bf16(ah, wh[ks], acc, 0, 0, 0);
                acc = __builtin_amdgcn_mfma_f32_32x32x16_bf16(ah, wl[ks], acc, 0, 0, 0);
                acc = __builtin_amdgcn_mfma_f32_32x32x16_bf16(al, wh[ks], acc, 0, 0, 0); }
            __syncthreads();
#pragma unroll
            for (int r = 0; r < 16; ++r) red[(c.wave * 32 + crow(r, hi)) * 33 + r32] = acc[r];
            __syncthreads();
            for (int i = c.tid; i < 1024; i += 512) { const int tk = i >> 5, e = i & 31; float s = brv;
#pragma unroll
                for (int w = 0; w < 8; ++w) s += red[(w * 32 + tk) * 33 + e];
                logit[tk * 33 + e] = s; }
            __syncthreads();
            if (c.tid < 32) { const int m = m0 + c.tid; const LAS float* lg = logit + c.tid * 33; float tv[4]; int te[4]; float x[32];
#pragma unroll
                for (int e = 0; e < 32; ++e) x[e] = lg[e];
#pragma unroll
                for (int k = 0; k < 4; ++k) { float best = x[0]; int be = 0;
#pragma unroll
                    for (int e = 1; e < 32; ++e) { if (x[e] > best) { best = x[e]; be = e; } }
#pragma unroll
                    for (int e = 0; e < 32; ++e) x[e] = (e == be) ? -INFINITY : x[e];
                    tv[k] = best; te[k] = be; }
                float gs = 0.f, gv[4];
#pragma unroll
                for (int k = 0; k < 4; ++k) { gv[k] = __expf(tv[k] - tv[0]); gs += gv[k]; }
#pragma unroll
                for (int k = 0; k < 4; ++k) { ME[m * 4 + k] = te[k]; MG[m * 4 + k] = gv[k] / gs; MR[m * 4 + k] = atomicAdd((int*)&lcnt[te[k]], 1); } }
            __syncthreads();
        }
        if (c.tid < 32) lcnt[32 + c.tid] = (int)atomicAdd(&gcnt[c.tid], (unsigned)lcnt[c.tid]);
        __syncthreads();
        if (c.tid < 256) { const int m = blk * 64 + (c.tid >> 2), k = c.tid & 3; const int e = ME[m * 4 + k]; const int rk = MR[m * 4 + k] + lcnt[32 + e]; MR[m * 4 + k] = rk; ((int*)(c.ws + WS_RANKTOK))[e * 16384 + rk] = m; }
        __syncthreads();
    }
}
constexpr int NPHASE = 20;
DI void refresh(Ctx& c, KP& p) {
    asm volatile("" : "+s"(p));
    int w_id = c.wave, z_ = 0; asm volatile("" : "+s"(w_id), "+v"(z_));
    c.wave = w_id; c.lane = (int)__builtin_amdgcn_mbcnt_hi(~0u, __builtin_amdgcn_mbcnt_lo(~0u, (unsigned)z_)); c.tid = w_id * 64 + c.lane;
    int g_ = gridDim.x, b_ = blockIdx.x; asm volatile("" : "+s"(g_), "+s"(b_)); c.G = g_; c.bx = b_;
    c.vcu = (g_ % 8 == 0) ? (b_ % 8) * (g_ / 8) + b_ / 8 : b_;
    c.gw = c.vcu * 8 + c.wave; c.NGW = g_ * 8;
    if (g_ == 256) { c.rbase = (c.vcu >> 5) * SEQ; c.rcnt = SEQ; c.lw = (c.vcu & 31) * 8 + c.wave; c.NLW = 256; } else { c.rbase = 0; c.rcnt = NTOK; c.lw = c.gw; c.NLW = c.NGW; }
    unsigned char* w_ = p->ws; asm volatile("" : "+s"(w_)); c.ws = w_;
    unsigned l_ = 0u; asm volatile("" : "+s"(l_)); c.lds = (LAS unsigned char*)(uintptr_t)l_;
}
template <int PH> DI void run_phase(KP p, const Ctx& c) {
    if constexpr (PH == 0) phase_prologue(p, c);
    else if constexpr (PH == NPHASE - 1) phase_final(p, c);
    else {
        constexpr int layer = (PH - 1) / 9, sub = (PH - 1) % 9;
        if constexpr (sub == 0) phase_norm_mix(p, c, layer);
        else if constexpr (sub == 1) {
            { SchedDense S{(const char*)(c.ws + WS_H8IN), (const char*)(c.ws + WS_WIN8) + (size_t)layer * D_INP * 1024, NTOK / 256, D_INP / 256, c.G, c.bx, (size_t)256 * 1024, layer != 0};
              EpiProj E{(bf16_t*)(c.ws + WS_PROJ), D_INP, 1.0f / (X_SCALE * W_SCALE)}; pg8::gemm_phase<true, false>(c.lds, c.tid, 512, S, E); }
            if constexpr (layer == 0) {
                if (c.bx >= 128) { __syncthreads(); big_convert(p, c, c.bx - 128, 128, SLOT_IN, BIG_ND, 0, BIG_L1); } } }
        else if constexpr (sub == 2) phase_prep_indexer(p, c, layer);
        else if constexpr (sub == 3) { SchedUp S{(const char*)(c.ws + WS_CQN), (const char*)(c.ws + WS_WUP) + (size_t)layer * 1792 * 256, c.G, c.bx};
            EpiProj E{(bf16_t*)(c.ws + WS_UPO), UPO_LD, 1.0f / (X_SCALE * W_SCALE)}; pg8::gemm_phase<true, false>(c.lds, c.tid, 128, S, E); }
        else if constexpr (sub == 4) phase_attention(p, c);
        else if constexpr (sub == 5) { SchedDense S{(const char*)(c.ws + WS_YBUF), (const char*)(c.ws + WS_WOUT) + (size_t)layer * 1024 * 1024, NTOK / 256, 4, c.G, c.bx, (size_t)256 * 1024};
            EpiOut<layer == 0> E{(bf16_t*)(c.ws + WS_XR), p->x, (const float*)(c.ws + WS_MODS) + layer * 8 * 6144 + 2 * 1024, 1.0f / (Y_SCALE * W_SCALE)}; pg8::gemm_phase<true, false>(c.lds, c.tid, 512, S, E); }
        else if constexpr (sub == 6) { phase_router(p, c, layer);
            if constexpr (layer == DEPTH - 1) { __syncthreads(); const int base = *(const LAS int*)(c.lds + LC_DEFER);
                big_convert(p, c, base + c.vcu, c.G, 1 << 20, BIG_ND, 0, BIG_L1); } }
        else if constexpr (sub == 7) {
            const int nt = build_tiles(c, layer);
            const LAS int* pst = (const LAS int*)(c.lds + LC_PST); const LAS int* tile_e = (const LAS int*)(c.lds + LC_TILEE); const LAS int* cnt = (const LAS int*)(c.lds + LC_CNT);
            LAS int* rowtab = (LAS int*)(c.lds + RT_OFF); const int* RANKTOK = (const int*)(c.ws + WS_RANKTOK);
            SchedMoeG S{(const char*)(c.ws + WS_XP8), (const char*)(c.ws + WS_W1) + (size_t)layer * 32 * 2048 * 1024, tile_e, rowtab, nt, 8, c.G, c.bx, layer != 0};
            { int tok[9];
#pragma unroll
              for (int i = 0; i < 9; ++i) { Unit u; tok[i] = -1; if (c.tid < 256 && S.next(i, u)) { const int e = tile_e[u.pm]; const int rk = (u.pm - pst[e]) * 256 + c.tid; tok[i] = rk < cnt[e] ? RANKTOK[e * 16384 + rk] : 0; } }
#pragma unroll
              for (int i = 0; i < 9; ++i) if (tok[i] >= 0) rowtab[i * 256 + c.tid] = tok[i] * 1024; }
            __syncthreads();
            EpiSwiglu E{c.ws + WS_HID8, p->b1 + (size_t)layer * 32 * 2048, tile_e}; pg8::gemm_phase<true, true>(c.lds, c.tid, 512, S, E);
            if constexpr (layer == 0) { int rx, nidx, before, nid;
                if (c.G == 256) pg8::moe_idle(nt, 8, c.bx & 7, rx, nidx, before, nid); else { rx = (nt * 8) % c.G; nid = rx ? c.G - rx : 0; before = 0; }
                const int rank = c.G == 256 ? (c.bx >> 3) : c.bx;
                if (rx && rank >= rx) { __syncthreads(); big_convert(p, c, 128 * SLOT_IN + before + (rank - rx), nid, SLOT_MOE, BIG_ND, 0, BIG_L1); }
                if (c.tid == 0) *(LAS int*)(c.lds + LC_DEFER) = 128 * SLOT_IN + SLOT_MOE * nid; } }
        else { const int nt = reuse_tiles(c, layer);
            SchedMoe S{(const char*)(c.ws + WS_HID8), (const char*)(c.ws + WS_W2) + (size_t)layer * 32 * 1024 * 1024, (const LAS int*)(c.lds + LC_TILEE), nt, 4, c.G, c.bx, layer != 0};
            EpiDown E{c.ws + WS_YEXP, p->b2 + (size_t)layer * 32 * 1024, (const LAS int*)(c.lds + LC_TILEE)}; pg8::gemm_phase<true, false>(c.lds, c.tid, 512, S, E);
            if constexpr (layer == 0) { int rx, nidx, before, nid; const int base = *(const LAS int*)(c.lds + LC_DEFER);
                if (c.G == 256) pg8::moe_idle(nt, 4, c.bx & 7, rx, nidx, before, nid); else { rx = (nt * 4) % c.G; nid = rx ? c.G - rx : 0; before = 0; }
                const int rank = c.G == 256 ? (c.bx >> 3) : c.bx;
                __syncthreads();
                if (rx && rank >= rx) big_convert(p, c, base + before + (rank - rx), nid, SLOT_MOE, BIG_ND, 0, BIG_L1);
                if (c.tid == 0) *(LAS int*)(c.lds + LC_DEFER) = base + SLOT_MOE * nid; } }
    }
}
__global__ void __launch_bounds__(512, 2) fwd_kernel(P p_arg, int ph_lo, int ph_hi) {
    extern __shared__ __attribute__((aligned(16))) unsigned char lds_raw[];
    KP p = (KP)__builtin_amdgcn_kernarg_segment_ptr();
    Ctx c; c.wave = __builtin_amdgcn_readfirstlane((int)threadIdx.x >> 6); refresh(c, p);
    for (int u = c.tid; u < (LDS_BYTES - LC_OFF) / 4; u += 512) ((LAS unsigned*)(c.lds + LC_OFF))[u] = 0u;
    __syncthreads();
#if !MULTI_LAUNCH
    XcdBarrier bar = xcd_barrier_post((unsigned*)(c.ws + WS_CTL) + CW_BAR, (volatile LAS unsigned*)(c.lds + LC_BARST), c.tid);
    if (c.tid == 0 && (bar.x != (unsigned)(c.bx & 7) || c.G != 256)) (void)xb_add((unsigned*)(c.ws + WS_CTL) + CW_MISMATCH, 1u);
#define SEAM_LOCAL(k) ((k) >= 1 && (k) < NPHASE - 1 && (((k) - 1) % 9 <= 5 || ((k) - 1) % 9 == 7))
#define SEAM(k) do { if ((k) + 1 < ph_hi) { xcd_barrier(bar, c.tid, SEAM_LOCAL(k)); \
        if ((k) == 0 && c.tid == 0) bar.st[2] = (xb_ld((unsigned*)(c.ws + WS_CTL) + CW_MISMATCH) == 0u) ? 1u : 0u; } } while (0)
#else
#define SEAM(k) do { } while (0)
#endif
#ifndef DBL_MASK
#define DBL_MASK 0u
#endif
#if MULTI_LAUNCH
#define REDO(k) do { } while (0)
#else
#define REDO(k) do { if constexpr (((DBL_MASK) >> (k)) & 1u) { xcd_barrier(bar, c.tid); refresh(c, p); run_phase<k>(p, c); } } while (0)
#endif
#define RUN(k) do { if (ph_lo <= (k) && (k) < ph_hi) { refresh(c, p); run_phase<k>(p, c); REDO(k); SEAM(k); } } while (0)
    RUN(0); RUN(1); RUN(2); RUN(3); RUN(4); RUN(5); RUN(6); RUN(7); RUN(8); RUN(9); RUN(10);
    RUN(11); RUN(12); RUN(13); RUN(14); RUN(15); RUN(16); RUN(17); RUN(18); RUN(19);
#undef RUN
#undef SEAM
}

extern "C" void kernel_launch(void* const* d_in, const int* in_sizes, int n_in, void* d_out, int out_size, void* d_ws, size_t ws_size, hipStream_t stream) {
    static int ready = 0;
    if (!ready) {
        if (n_in != 21 || ws_size < WS_END || out_size != NTOK * DM) { fprintf(stderr, "kernel_launch: unexpected shapes (n_in %d, ws %zu, out %d)\n", n_in, ws_size, out_size); ready = -1; return; }
        if (hipFuncSetAttribute((const void*)fwd_kernel, hipFuncAttributeMaxDynamicSharedMemorySize, LDS_BYTES) != hipSuccess) { fprintf(stderr, "kernel_launch: hipFuncSetAttribute failed\n"); ready = -1; return; }
        int per_cu = 0; (void)hipOccupancyMaxActiveBlocksPerMultiprocessor(&per_cu, (const void*)fwd_kernel, 512, LDS_BYTES); (void)hipGetLastError();
        if (per_cu < 1) { fprintf(stderr, "kernel_launch: occupancy query says %d workgroups per CU; the grid barrier needs every workgroup resident; nothing launched\n", per_cu); ready = -1; return; }
        ready = 1;
    }
    if (ready < 0) return;
    (void)hipMemsetAsync((char*)d_ws + WS_CTL, 0, CTL_BYTES, stream);
    P p{};
    p.x = (const float*)d_in[0]; p.c = (const float*)d_in[1]; p.pos = (const int*)d_in[2]; p.rel_bias = (const float*)d_in[3]; p.norm_mix = (const float*)d_in[4];
    p.w_ada = (const float*)d_in[5]; p.b_ada = (const float*)d_in[6]; p.w_in = (const float*)d_in[7]; p.q_norm = (const float*)d_in[8]; p.w_uq = (const float*)d_in[9];
    p.kv_norm = (const float*)d_in[10]; p.w_ukv = (const float*)d_in[11]; p.w_out = (const float*)d_in[12]; p.norm_ffn = (const float*)d_in[13]; p.w_router = (const float*)d_in[14];
    p.b_router = (const float*)d_in[15]; p.w1 = (const float*)d_in[16]; p.b1 = (const float*)d_in[17]; p.w2 = (const float*)d_in[18]; p.b2 = (const float*)d_in[19]; p.norm_final = (const float*)d_in[20];
    p.out = (float*)d_out; p.ws = (unsigned char*)d_ws;
#if MULTI_LAUNCH
    for (int ph = 0; ph < NPHASE; ++ph) hipLaunchKernelGGL(fwd_kernel, dim3(256), dim3(512), LDS_BYTES, stream, p, ph, ph + 1);
#else
    int lo = 0, hi = NPHASE; void* args[] = {&p, &lo, &hi};
    hipError_t e = hipLaunchCooperativeKernel((const void*)fwd_kernel, dim3(256), dim3(512), args, LDS_BYTES, stream);
    if (e != hipSuccess) fprintf(stderr, "cooperative launch failed: %s\n", hipGetErrorString(e));
#endif
}
```
